# Optimizing an MI355X kernel written in HIP

```python
import jax, jax.numpy as jnp
from jax import lax
import numpy as np

D_MODEL = 1024
BATCH = 8
SEQ = 4096
DEPTH = 1

GRID_W = 64
CTX_LEN = 256

F_GROUP_W = 128
F_WIDTH = D_MODEL // 2
F_GROUPS = F_WIDTH // F_GROUP_W

D_INNER = (3 * D_MODEL) // 2
SSD_HEAD_DIM = 64
SSD_HEADS = D_INNER // SSD_HEAD_DIM
SSD_GROUPS = 4
D_STATE = 128
CONV_W = 3
CHUNK = 128
CONV_CH = D_INNER + 2 * SSD_GROUPS * D_STATE

N_BRANCH = 2
P_IN = F_WIDTH + D_INNER + CONV_CH + 2 * SSD_HEADS + N_BRANCH * D_MODEL

N_EXPERTS = 16
EC_FACTOR = 2
EXPERT_FF = D_MODEL

N_MOD = 6
RMS_EPS = 1e-6

kernel_name = "hybrid_fnet_ssd_ec_moe_dit_block"


def rms_norm(x, w):
    xf = x.astype(jnp.float32)
    y = xf * lax.rsqrt(jnp.mean(xf * xf, axis=-1, keepdims=True) + RMS_EPS)
    return (y * w.astype(jnp.float32)).astype(x.dtype)


def modulate(x, gain, shift, scale):
    return rms_norm(x, gain) * (1 + scale) + shift


def centred_dwconv(u, w, b, n_rows):
    bn, length, ch = u.shape
    row_len = length // n_rows
    r = u.reshape(bn, n_rows, row_len, ch)
    pad = CONV_W // 2
    rp = jnp.pad(r, ((0, 0), (0, 0), (pad, pad), (0, 0)))
    out = sum(rp[:, :, k:k + row_len] * w[k] for k in range(CONV_W)) + b
    return out.reshape(bn, length, ch)


def ssd_chunked(xh, dt, a, bm, cm, h0):
    bn, length, nh, hp = xh.shape
    g, n = bm.shape[2], bm.shape[3]
    hg = nh // g
    nc = length // CHUNK
    x = xh.reshape(bn, nc, CHUNK, g, hg, hp)
    dtc = dt.reshape(bn, nc, CHUNK, g, hg)
    bc = bm.reshape(bn, nc, CHUNK, g, n)
    cc = cm.reshape(bn, nc, CHUNK, g, n)
    acum = jnp.cumsum(dtc * a.reshape(g, hg), axis=2)
    xdt = x * dtc[..., None]
    seg = acum[:, :, :, None] - acum[:, :, None, :]
    lower = jnp.tril(jnp.ones((CHUNK, CHUNK), dtype=bool))[:, :, None, None]
    decay = jnp.where(lower, jnp.exp(jnp.where(lower, seg, 0.0)), 0.0)
    cb = jnp.einsum('bctgn,bcsgn->bctsg', cc, bc)
    y_diag = jnp.einsum('bctsg,bctsgh,bcsghp->bctghp', cb, decay, xdt)
    decay_end = jnp.exp(acum[:, :, -1:] - acum)
    states = jnp.einsum('bcsgn,bcsgh,bcsghp->bcghpn', bc, decay_end, xdt)
    chunk_decay = jnp.exp(acum[:, :, -1])

    def step(h, inp):
        dec, st = inp
        return dec[..., None, None] * h + st, h

    h_final, h_prev = lax.scan(step, h0, (jnp.moveaxis(chunk_decay, 1, 0), jnp.moveaxis(states, 1, 0)))
    h_prev = jnp.moveaxis(h_prev, 0, 1)
    y_off = jnp.einsum('bctgn,bctgh,bcghpn->bctghp', cc, jnp.exp(acum), h_prev)
    y = (y_diag + y_off).reshape(bn, length, nh, hp)
    return y, h_final


def bidir_ssd(xh, dt_raw, bm, cm, dt_bias, a_log, h0_f, h0_b):
    dt_f = jax.nn.softplus(dt_raw[:, :, 0] + dt_bias[0])
    dt_b = jax.nn.softplus(dt_raw[:, :, 1] + dt_bias[1])
    a_f = -jnp.exp(a_log[0].astype(jnp.float32))
    a_b = -jnp.exp(a_log[1].astype(jnp.float32))
    y_f, h_f = ssd_chunked(xh, dt_f, a_f, bm, cm, h0_f)
    flip = lambda t: jnp.flip(t, axis=1)
    y_b, h_b = ssd_chunked(flip(xh), flip(dt_b), a_b, flip(bm), flip(cm), h0_b)
    return y_f + flip(y_b), h_f, h_b


def token_mixer(h, n_rows, h0_f, h0_b, w_in, conv_w, conv_b, dt_bias, a_log, d_skip, ssd_norm,
                w_fourier, w_ssd_out, b_gate, w_out):
    bn, length, _ = h.shape
    proj = h @ w_in
    i1 = F_WIDTH
    i2 = i1 + D_INNER
    i3 = i2 + CONV_CH
    i4 = i3 + 2 * SSD_HEADS
    u_f, z, xbc, dt_raw, gate_logits = jnp.split(proj, [i1, i2, i3, i4], axis=-1)
    uf = u_f.reshape(bn, length, F_GROUPS, F_GROUP_W).astype(jnp.float32)
    f = jnp.fft.fft2(uf, axes=(1, 3), norm='ortho').real.astype(h.dtype).reshape(bn, length, F_WIDTH)
    f_branch = f @ w_fourier
    xbc = jax.nn.silu(centred_dwconv(xbc, conv_w, conv_b, n_rows))
    xs, bm, cm = jnp.split(xbc, [D_INNER, D_INNER + SSD_GROUPS * D_STATE], axis=-1)
    xh = xs.reshape(bn, length, SSD_HEADS, SSD_HEAD_DIM).astype(jnp.float32)
    bm = bm.reshape(bn, length, SSD_GROUPS, D_STATE).astype(jnp.float32)
    cm = cm.reshape(bn, length, SSD_GROUPS, D_STATE).astype(jnp.float32)
    dt_raw = dt_raw.reshape(bn, length, 2, SSD_HEADS).astype(jnp.float32)
    y, h_f, h_b = bidir_ssd(xh, dt_raw, bm, cm, dt_bias, a_log, h0_f, h0_b)
    y = y + d_skip[:, None].astype(jnp.float32) * xh
    y = y.reshape(bn, length, D_INNER).astype(h.dtype)
    y = rms_norm(y * jax.nn.silu(z), ssd_norm)
    s_branch = y @ w_ssd_out
    g = jax.nn.sigmoid(gate_logits.reshape(bn, length, N_BRANCH, D_MODEL) + b_gate)
    merged = g[:, :, 0] * f_branch + g[:, :, 1] * s_branch
    return merged @ w_out, h_f, h_b


def expert_choice_ffn(h, w_router, w_e_gate, w_e_up, w_e_down):
    bn, length, d = h.shape
    cap = EC_FACTOR * length // N_EXPERTS
    aff = jax.nn.softmax((h @ w_router).astype(jnp.float32), axis=-1)
    top_aff, top_idx = lax.top_k(jnp.swapaxes(aff, 1, 2), cap)
    xe = jax.vmap(lambda hb, ib: hb[ib])(h, top_idx)
    hid = jax.nn.silu(jnp.einsum('becd,edf->becf', xe, w_e_gate)) * jnp.einsum('becd,edf->becf', xe, w_e_up)
    ye = jnp.einsum('becf,efd->becd', hid, w_e_down) * top_aff[..., None].astype(h.dtype)
    return jax.vmap(lambda ib, yb: jnp.zeros((length, d), yb.dtype).at[ib.reshape(-1)].add(yb.reshape(-1, d)))(top_idx, ye)


def setup_inputs(seed: int = 0) -> dict:
    key = jax.random.key(seed)
    ks = jax.random.split(key, 32)
    nrm = lambda k, shape, s: jax.random.normal(k, shape, jnp.float32) * s
    L = DEPTH
    dt0 = jnp.exp(jax.random.uniform(ks[12], (L, 2, SSD_HEADS), jnp.float32, np.log(1e-3), np.log(1e-1)))
    return {
        'x': nrm(ks[0], (BATCH, SEQ, D_MODEL), 1.0),
        'c': nrm(ks[1], (BATCH, D_MODEL), 1.0),
        'ctx': nrm(ks[2], (BATCH, CTX_LEN, D_MODEL), 1.0),
        'c_ctx': nrm(ks[3], (D_MODEL,), 1.0),
        'w_mod': nrm(ks[4], (L, D_MODEL, N_MOD * D_MODEL), 0.5 * D_MODEL ** -0.5),
        'b_mod': nrm(ks[5], (L, N_MOD * D_MODEL), 0.02),
        'norm_mix_pre': 1.0 + nrm(ks[6], (L, D_MODEL), 0.05),
        'norm_mix_post': 1.0 + nrm(ks[7], (L, D_MODEL), 0.05),
        'norm_ffn_pre': 1.0 + nrm(ks[8], (L, D_MODEL), 0.05),
        'norm_ffn_post': 1.0 + nrm(ks[9], (L, D_MODEL), 0.05),
        'w_in': nrm(ks[10], (L, D_MODEL, P_IN), D_MODEL ** -0.5),
        'conv_w': nrm(ks[11], (L, CONV_W, CONV_CH), CONV_W ** -0.5),
        'conv_b': nrm(ks[13], (L, CONV_CH), 0.02),
        'dt_bias': dt0 + jnp.log(-jnp.expm1(-dt0)),
        'a_log': jnp.log(jax.random.uniform(ks[14], (L, 2, SSD_HEADS), jnp.float32, 1.0, 16.0)),
        'd_skip': 1.0 + nrm(ks[15], (L, SSD_HEADS), 0.1),
        'ssd_norm': 1.0 + nrm(ks[16], (L, D_INNER), 0.05),
        'w_fourier': nrm(ks[17], (L, F_WIDTH, D_MODEL), F_WIDTH ** -0.5),
        'w_ssd_out': nrm(ks[18], (L, D_INNER, D_MODEL), D_INNER ** -0.5),
        'b_gate': nrm(ks[19], (L, N_BRANCH, D_MODEL), 0.1),
        'w_out': nrm(ks[20], (L, D_MODEL, D_MODEL), D_MODEL ** -0.5),
        'w_router': nrm(ks[21], (L, D_MODEL, N_EXPERTS), D_MODEL ** -0.5),
        'w_e_gate': nrm(ks[22], (L, N_EXPERTS, D_MODEL, EXPERT_FF), D_MODEL ** -0.5),
        'w_e_up': nrm(ks[23], (L, N_EXPERTS, D_MODEL, EXPERT_FF), D_MODEL ** -0.5),
        'w_e_down': nrm(ks[24], (L, N_EXPERTS, EXPERT_FF, D_MODEL), EXPERT_FF ** -0.5),
    }


def reference(x, c, ctx, c_ctx, w_mod, b_mod, norm_mix_pre, norm_mix_post, norm_ffn_pre, norm_ffn_post,
              w_in, conv_w, conv_b, dt_bias, a_log, d_skip, ssd_norm, w_fourier, w_ssd_out, b_gate, w_out,
              w_router, w_e_gate, w_e_up, w_e_down):
    bn, length, d = x.shape
    rows = length // GRID_W
    hx, hc = x, ctx
    for l in range(DEPTH):
        mod_x = (jax.nn.silu(c) @ w_mod[l] + b_mod[l]).reshape(bn, N_MOD, 1, d)
        mod_c = (jax.nn.silu(c_ctx) @ w_mod[l] + b_mod[l]).reshape(N_MOD, d)
        sh1, sc1, g1, sh2, sc2, g2 = [mod_x[:, i] for i in range(N_MOD)]
        csh1, csc1, cg1, csh2, csc2, cg2 = [mod_c[i] for i in range(N_MOD)]
        mix_w = (w_in[l], conv_w[l], conv_b[l], dt_bias[l], a_log[l], d_skip[l], ssd_norm[l],
                 w_fourier[l], w_ssd_out[l], b_gate[l], w_out[l])
        h0 = jnp.zeros((bn, SSD_GROUPS, SSD_HEADS // SSD_GROUPS, SSD_HEAD_DIM, D_STATE), jnp.float32)
        mix_c, hf_c, hb_c = token_mixer(modulate(hc, norm_mix_pre[l], csh1, csc1), 1, h0, h0, *mix_w)
        mix_x, _, _ = token_mixer(modulate(hx, norm_mix_pre[l], sh1, sc1), rows, hf_c, hb_c, *mix_w)
        hx = hx + g1 * rms_norm(mix_x, norm_mix_post[l])
        ffn_x = expert_choice_ffn(modulate(hx, norm_ffn_pre[l], sh2, sc2), w_router[l], w_e_gate[l], w_e_up[l], w_e_down[l])
        hx = hx + g2 * rms_norm(ffn_x, norm_ffn_post[l])
        if l + 1 < DEPTH:
            hc = hc + cg1 * rms_norm(mix_c, norm_mix_post[l])
            ffn_c = expert_choice_ffn(modulate(hc, norm_ffn_pre[l], csh2, csc2), w_router[l], w_e_gate[l], w_e_up[l], w_e_down[l])
            hc = hc + cg2 * rms_norm(ffn_c, norm_ffn_post[l])
    return hx
```

```cpp
#include <hip/hip_runtime.h>
#include <hip/hip_cooperative_groups.h>
#include <stdint.h>
#include <cstdio>
namespace cg = cooperative_groups;
#define NT 512

typedef unsigned short bf16_t;
typedef short bf16x8 __attribute__((ext_vector_type(8)));
typedef float f32x4 __attribute__((ext_vector_type(4)));

#define D_MODEL 1024
#define BATCH 8
#define SEQ 4096
#define CTX 256
#define NLAT (BATCH * SEQ)
#define NCTX (BATCH * CTX)
#define NTOK (NLAT + NCTX)
#define F_WIDTH 512
#define D_INNER 1536
#define CONV_CH 2560
#define NHEADS 24
#define P_IN 6704
#define N_EXP 16
#define CAP 512
#define RMS_EPS 1e-6f
#define SMEM_BYTES (153600 + 64)
#define XB_LDS_OFF 153600
#define MERGED_RS_OFF 131072
#define CONVT_OFF 133120
#define PREP2_SPLIT 4608

__device__ __forceinline__ bf16_t f2bf(float f) { unsigned u = __float_as_uint(f); u += 0x7FFFu + ((u >> 16) & 1u); return (bf16_t)(u >> 16); }
__device__ __forceinline__ float bf2f(bf16_t b) { return __uint_as_float(((unsigned)b) << 16); }
__device__ __forceinline__ float frcp(float v) { return __builtin_amdgcn_rcpf(v); }
__device__ __forceinline__ float siluf(float v) { return v * frcp(1.0f + __expf(-v)); }
__device__ __forceinline__ float clamp8(float v) { return __builtin_amdgcn_fmed3f(v, -448.0f, 448.0f); }
__device__ __forceinline__ float sigmoidf(float v) { return frcp(1.0f + __expf(-v)); }
__device__ __forceinline__ int otid() { int t = threadIdx.x; asm volatile("" : "+v"(t)); return t; }
#define WAVE_DPP(v, ctrl) __int_as_float(__builtin_amdgcn_update_dpp(0, __float_as_int(v), ctrl, 0xF, 0xF, false))
__device__ __forceinline__ float wave_sum(float v) {
    v += WAVE_DPP(v, 0xB1); v += WAVE_DPP(v, 0x4E); v += WAVE_DPP(v, 0x141); v += WAVE_DPP(v, 0x140);
    const int vi = __float_as_int(v);
    return (__int_as_float(__builtin_amdgcn_readlane(vi, 0)) + __int_as_float(__builtin_amdgcn_readlane(vi, 16))) + (__int_as_float(__builtin_amdgcn_readlane(vi, 32)) + __int_as_float(__builtin_amdgcn_readlane(vi, 48)));
}
__device__ __forceinline__ float wave_max(float v) {
    v = fmaxf(v, WAVE_DPP(v, 0xB1)); v = fmaxf(v, WAVE_DPP(v, 0x4E)); v = fmaxf(v, WAVE_DPP(v, 0x141)); v = fmaxf(v, WAVE_DPP(v, 0x140));
    const int vi = __float_as_int(v);
    return fmaxf(fmaxf(__int_as_float(__builtin_amdgcn_readlane(vi, 0)), __int_as_float(__builtin_amdgcn_readlane(vi, 16))), fmaxf(__int_as_float(__builtin_amdgcn_readlane(vi, 32)), __int_as_float(__builtin_amdgcn_readlane(vi, 48))));
}

struct Params {
    const float *x, *c, *ctx, *c_ctx, *w_mod, *b_mod, *norm_mix_pre, *norm_mix_post, *norm_ffn_pre, *norm_ffn_post;
    const float *w_in, *conv_w, *conv_b, *dt_bias, *a_log, *d_skip, *ssd_norm, *w_fourier, *w_ssd_out, *b_gate, *w_out;
    const float *w_router, *w_e_gate, *w_e_up, *w_e_down;
    float* out;
    float* mod;
    bf16_t* h;
    bf16_t* uf;
    bf16_t* z;
    bf16_t* xbc;
    float* dtraw;
    unsigned char* gq;
    bf16_t* pq;
    bf16_t* f;
    bf16_t* y;
    bf16_t* merged;
    bf16_t* mix;
    bf16_t* h2;
    float* aff;
    int* topidx;
    float* topaff;
    int* slot_of;
    bf16_t* hid;
    bf16_t* ye;
    bf16_t* av;
    bf16_t* ufT;
    bf16_t* dmat;
    bf16_t* ueT;
    bf16_t* uoT;
    float* umid;
    float* ualt;
    bf16_t* WinT;
    bf16_t* WmT;
    bf16_t* WoT;
    bf16_t* WguT;
    bf16_t* WdT;
    float* ssq;
    bf16_t* hx1;
    unsigned char* h2q;
    signed char* hq;
    float* hscale;
    signed char* WinQ;
    float* wscale;
    unsigned* colmax;
    unsigned char* hid8;
    unsigned char* WguT8;
    unsigned char* WdT8;
};
#define AVLD 2560


#define LAS __attribute__((address_space(3)))
typedef unsigned u32x4 __attribute__((ext_vector_type(4)));
typedef unsigned u32x2 __attribute__((ext_vector_type(2)));
namespace g8 {
constexpr int BM = 256, BK = 64, HALF = 128, HTB = HALF * BK * 2, STAGE_BYTES = 8 * HTB;
__device__ __forceinline__ int lds_byte(int r, int c) { const int st = (r >> 4) * 2 + (c >> 5), rr = r & 15, cc = c & 31, ob = rr * 64 + cc * 2; return st * 1024 + (ob ^ (((ob >> 9) & 1) << 5)); }
__device__ __forceinline__ void stage_rc(int b, int& R, int& C) { const int st = b / 1024, sb = b % 1024, swz = sb ^ (((sb >> 9) & 1) << 5); R = (st >> 1) * 16 + swz / 64; C = (st & 1) * 32 + (swz % 64) / 2; }
__device__ __forceinline__ int perm32(int rho) { const int n = rho >> 4, i = rho & 15; return 8 * (i >> 2) + 4 * n + (i & 3); }
typedef float f32x2_ __attribute__((ext_vector_type(2)));
typedef __bf16 bf16x2_ __attribute__((ext_vector_type(2)));
__device__ __forceinline__ unsigned cvt_pk_bf16(float lo, float hi) { union { bf16x2_ b; unsigned u; } cv; cv.b = __builtin_convertvector((f32x2_){lo, hi}, bf16x2_); return cv.u; }
struct Unit { const char* A; const char* B; const int* gidx; int nt, pm, pn, aux; };
__device__ __forceinline__ void grid_map(int L, int nM, int nN, int& pm, int& pn) {
    const int nwg = nM * nN; int wgid = L;
    { const int q = nwg / 8, r = nwg % 8, xcd = wgid % 8, off = wgid / 8; wgid = (xcd < r ? xcd * (q + 1) : r * (q + 1) + (xcd - r) * q) + off; }
    const int nig = 8 * nN, gid = wgid / nig, fm = gid * 8, gsz = (nM - fm) < 8 ? (nM - fm) : 8;
    pm = fm + ((wgid % nig) % gsz); pn = (wgid % nig) / gsz;
}
typedef int i32x8 __attribute__((ext_vector_type(8)));
typedef int i32x4v __attribute__((ext_vector_type(4)));
__device__ __forceinline__ i32x8 cat16(const bf16x8 lo, const bf16x8 hi) { union { bf16x8 b; i32x4v i; } a, c; a.b = lo; c.b = hi; return __builtin_shufflevector(a.i, c.i, 0, 1, 2, 3, 4, 5, 6, 7); }
template <class Epi, class Sched, bool GATHER, bool FP8 = false, bool I8 = false>
__device__ __forceinline__ void gemm8(LAS unsigned char* lds, const unsigned lda, const unsigned ldb, const Sched& S, const Epi& E) {
    int tid_ = threadIdx.x; asm volatile("" : "+v"(tid_));
    const int tid = tid_, wid = __builtin_amdgcn_readfirstlane(tid >> 6), lane = tid & 63, wr = wid >> 2, wc = wid & 3, fr = lane & 15, fq = lane >> 4;
    unsigned voffB[2], va[2][2], vn[2][2]; int RA[2], CA[2];
#pragma unroll
    for (int i = 0; i < 2; ++i) { int R, C; stage_rc(tid * 16 + i * 8192, R, C); const int Rb = Epi::PERM ? ((R & ~31) + perm32(R & 31)) : R;
        RA[i] = R; CA[i] = C; voffB[i] = (unsigned)Rb * ldb + (unsigned)C * 2u; va[0][i] = (unsigned)R * lda + (unsigned)C * 2u; va[1][i] = (unsigned)(R + HALF) * lda + (unsigned)C * 2u; vn[0][i] = va[0][i]; vn[1][i] = va[1][i]; }
    const size_t kstep = (size_t)(BK * 2);
    const size_t hstepB = (size_t)HALF * ldb;
    const unsigned ldsw = (unsigned)wid * 1024u;
    const int aoff = lds_byte(wr * 64 + fr, fq * 8), boff = lds_byte(wc * 32 + fr, fq * 8);
#define G8_SA(b, h) (((b) * 2 + (h)) * HTB)
#define G8_SB(b, h) ((4 + (b) * 2 + (h)) * HTB)
#define G8_STAGE(bufoff, gbase, v0, v1) do { \
        __builtin_amdgcn_global_load_lds((const unsigned*)((const char*)(gbase) + (v0)), (LAS unsigned*)(lds + (bufoff) + ldsw), 16, 0, 0); \
        __builtin_amdgcn_global_load_lds((const unsigned*)((const char*)(gbase) + (v1)), (LAS unsigned*)(lds + (bufoff) + ldsw + 8192), 16, 0, 0); } while (0)
#define G8_LDA(dst, b, h) do { if constexpr (FP8) { _Pragma("unroll") for (int m = 0; m < 4; ++m) { const i32x4v lo_ = *(const LAS i32x4v*)(lds + G8_SA(b, h) + aoff + m * 2048), hi_ = *(const LAS i32x4v*)(lds + G8_SA(b, h) + aoff + m * 2048 + 1024); dst##8[m] = __builtin_shufflevector(lo_, hi_, 0, 1, 2, 3, 4, 5, 6, 7); } } \
        else { _Pragma("unroll") for (int m = 0; m < 4; ++m) _Pragma("unroll") for (int k = 0; k < 2; ++k) dst[m][k] = *(const LAS bf16x8*)(lds + G8_SA(b, h) + aoff + m * 2048 + k * 1024); } } while (0)
#define G8_LDB(dst, b, h) do { if constexpr (FP8) { _Pragma("unroll") for (int n = 0; n < 2; ++n) { const i32x4v lo_ = *(const LAS i32x4v*)(lds + G8_SB(b, h) + boff + n * 2048), hi_ = *(const LAS i32x4v*)(lds + G8_SB(b, h) + boff + n * 2048 + 1024); dst##8[n] = __builtin_shufflevector(lo_, hi_, 0, 1, 2, 3, 4, 5, 6, 7); } } \
        else { _Pragma("unroll") for (int n = 0; n < 2; ++n) _Pragma("unroll") for (int k = 0; k < 2; ++k) dst[n][k] = *(const LAS bf16x8*)(lds + G8_SB(b, h) + boff + n * 2048 + k * 1024); } } while (0)
#define G8_MMA(ai, bj, At, Bt) do { __builtin_amdgcn_s_setprio(1); \
        if constexpr (FP8) { _Pragma("unroll") for (int m = 0; m < 4; ++m) _Pragma("unroll") for (int n = 0; n < 2; ++n) \
            asm volatile("v_mfma_scale_f32_16x16x128_f8f6f4 %0, %1, %2, %0, %3, %4 op_sel_hi:[0,0,0]" : "+v"(acc[ai][bj][m][n]) : "v"(Bt##8[n]), "v"(At##8[m]), "v"(sclb), "v"(scla)); } \
        else if constexpr (I8) { _Pragma("unroll") for (int m = 0; m < 4; ++m) _Pragma("unroll") for (int n = 0; n < 2; ++n) _Pragma("unroll") for (int k = 0; k < 2; ++k) \
            acc[ai][bj][m][n] = __builtin_bit_cast(f32x4, __builtin_amdgcn_mfma_i32_16x16x64_i8(__builtin_bit_cast(i32x4v, Bt[n][k]), __builtin_bit_cast(i32x4v, At[m][k]), __builtin_bit_cast(i32x4v, acc[ai][bj][m][n]), 0, 0, 0)); } \
        else { _Pragma("unroll") for (int m = 0; m < 4; ++m) _Pragma("unroll") for (int n = 0; n < 2; ++n) _Pragma("unroll") for (int k = 0; k < 2; ++k) \
            acc[ai][bj][m][n] = __builtin_amdgcn_mfma_f32_16x16x32_bf16(Bt[n][k], At[m][k], acc[ai][bj][m][n], 0, 0, 0); } \
        __builtin_amdgcn_s_setprio(0); } while (0)
#define G8_WAIT_V(n) asm volatile("s_waitcnt vmcnt(" #n ")" ::: "memory")
#define G8_WAIT_L(n) asm volatile("s_waitcnt lgkmcnt(" #n ")" ::: "memory")
#define G8_BAR __builtin_amdgcn_s_barrier()
#define G8_SCHED __builtin_amdgcn_sched_barrier(0)
    Unit cur, nxt; int ui = 0;
    if (!S.next(0, cur)) return;
    if (GATHER) {
#pragma unroll
        for (int i = 0; i < 2; ++i) { va[0][i] = (unsigned)cur.gidx[RA[i]] * lda + (unsigned)CA[i] * 2u; va[1][i] = (unsigned)cur.gidx[RA[i] + HALF] * lda + (unsigned)CA[i] * 2u; }
    }
    f32x4 acc[2][2][4][2];
#pragma unroll
    for (int a = 0; a < 2; ++a)
#pragma unroll
        for (int b = 0; b < 2; ++b)
#pragma unroll
            for (int m = 0; m < 4; ++m)
#pragma unroll
                for (int n = 0; n < 2; ++n) acc[a][b][m][n] = (f32x4){0.f, 0.f, 0.f, 0.f};
    bf16x8 At[4][2], B0[2][2], B1[2][2];
    i32x8 At8[4], B08[2], B18[2];
    int scla = 0x7F7F7F7F, sclb = 0x7F7F7F7F; if constexpr (FP8) { scla = Epi::SCALE_A; sclb = Epi::SCALE_B; }
    const char* cA = cur.A; const char* cB = cur.B;
    G8_STAGE(G8_SB(0, 0), cB, voffB[0], voffB[1]); G8_STAGE(G8_SA(0, 0), cA, va[0][0], va[0][1]); G8_STAGE(G8_SB(0, 1), cB + hstepB, voffB[0], voffB[1]); G8_STAGE(G8_SA(0, 1), cA, va[1][0], va[1][1]);
    if (wr == 1) G8_BAR;
    G8_WAIT_V(4); G8_BAR;
    G8_STAGE(G8_SB(1, 0), cB + kstep, voffB[0], voffB[1]); G8_STAGE(G8_SA(1, 0), cA + kstep, va[0][0], va[0][1]); G8_STAGE(G8_SB(1, 1), cB + hstepB + kstep, voffB[0], voffB[1]);
    G8_WAIT_V(6); G8_BAR;
    for (;;) {
        const bool has_next = S.next(ui + 1, nxt);
        const char* nA = has_next ? nxt.A : cA; const char* nB = has_next ? nxt.B : cB;
        if (GATHER) {
            if (has_next) {
#pragma unroll
                for (int i = 0; i < 2; ++i) { vn[0][i] = (unsigned)nxt.gidx[RA[i]] * lda + (unsigned)CA[i] * 2u; vn[1][i] = (unsigned)nxt.gidx[RA[i] + HALF] * lda + (unsigned)CA[i] * 2u; }
            } else {
#pragma unroll
                for (int i = 0; i < 2; ++i) { vn[0][i] = va[0][i]; vn[1][i] = va[1][i]; }
            }
        }
        const int nt = cur.nt;
        for (int t = 0; t < nt; t += 2) {
            const bool last = (t == nt - 2);
            const char* a1 = cA + (size_t)(t + 1) * kstep;
            const char* a2 = last ? nA : cA + (size_t)(t + 2) * kstep; const char* b2 = last ? nB : cB + (size_t)(t + 2) * kstep;
            const char* a3 = a2 + kstep; const char* b3 = b2 + kstep;
            const unsigned w00 = (GATHER && last) ? vn[0][0] : va[0][0], w01 = (GATHER && last) ? vn[0][1] : va[0][1];
            const unsigned w10 = (GATHER && last) ? vn[1][0] : va[1][0], w11 = (GATHER && last) ? vn[1][1] : va[1][1];
            G8_LDB(B0, 0, 0); G8_SCHED; G8_LDA(At, 0, 0); G8_STAGE(G8_SA(1, 1), a1, va[1][0], va[1][1]);
            G8_WAIT_L(8); G8_BAR; G8_WAIT_L(0); G8_MMA(0, 0, At, B0); G8_BAR; G8_SCHED;
            G8_LDB(B1, 0, 1); G8_STAGE(G8_SB(0, 0), b2, voffB[0], voffB[1]);
            G8_BAR; G8_WAIT_L(0); G8_MMA(0, 1, At, B1); G8_BAR;
            G8_LDA(At, 0, 1); G8_STAGE(G8_SA(0, 0), a2, w00, w01);
            G8_BAR; G8_WAIT_L(0); G8_MMA(1, 0, At, B0); G8_BAR; G8_SCHED;
            G8_STAGE(G8_SB(0, 1), b2 + hstepB, voffB[0], voffB[1]);
            G8_WAIT_V(6); G8_BAR; G8_MMA(1, 1, At, B1); G8_BAR;
            G8_LDB(B0, 1, 0); G8_SCHED; G8_LDA(At, 1, 0); G8_STAGE(G8_SA(0, 1), a2, w10, w11);
            G8_WAIT_L(8); G8_BAR; G8_WAIT_L(0); G8_MMA(0, 0, At, B0); G8_BAR; G8_SCHED;
            G8_LDB(B1, 1, 1); G8_STAGE(G8_SB(1, 0), b3, voffB[0], voffB[1]);
            G8_BAR; G8_WAIT_L(0); G8_MMA(0, 1, At, B1); G8_BAR;
            G8_LDA(At, 1, 1); G8_STAGE(G8_SA(1, 0), a3, w00, w01);
            G8_BAR; G8_WAIT_L(0); G8_MMA(1, 0, At, B0); G8_BAR; G8_SCHED;
            G8_STAGE(G8_SB(1, 1), b3 + hstepB, voffB[0], voffB[1]);
            G8_WAIT_V(6); G8_BAR; G8_MMA(1, 1, At, B1); G8_BAR;
        }
        if constexpr (FP8) asm volatile("s_nop 15\n\ts_nop 15\n\ts_nop 15" ::: "memory");
        const bool keep = E(acc, cur, wr, wc, fr, fq);
        if (!has_next) break;
        if (!keep) {
#pragma unroll
            for (int a = 0; a < 2; ++a)
#pragma unroll
                for (int b = 0; b < 2; ++b)
#pragma unroll
                    for (int m = 0; m < 4; ++m)
#pragma unroll
                        for (int n = 0; n < 2; ++n) acc[a][b][m][n] = (f32x4){0.f, 0.f, 0.f, 0.f};
        }
        cur = nxt; cA = nA; cB = nB; ++ui;
        if (GATHER) {
#pragma unroll
            for (int i = 0; i < 2; ++i) { va[0][i] = vn[0][i]; va[1][i] = vn[1][i]; }
        }
    }
    G8_WAIT_V(0);
    if (wr == 0) G8_BAR;
    G8_BAR;
#undef G8_SA
#undef G8_SB
#undef G8_STAGE
#undef G8_LDA
#undef G8_LDB
#undef G8_MMA
#undef G8_WAIT_V
#undef G8_WAIT_L
#undef G8_BAR
#undef G8_SCHED
}
}


#define XB_TMO      128
#define XB_XCNT(j)  (256  + 64 * (j))
#define XB_XSUB(j)  (1280 + 64 * (j))
#define XB_XGEN(j)  (2304 + 64 * (j))
#define XB_TOP      3328
#define XB_TOPGEN   3392
#define XCD_BAR_WORDS 3456
#define XB_SPIN_CAP (1u << 20)
__device__ __forceinline__ unsigned xb_ld(unsigned* p)              { return __hip_atomic_load(p, __ATOMIC_RELAXED, __HIP_MEMORY_SCOPE_AGENT); }
__device__ __forceinline__ unsigned xb_add(unsigned* p, unsigned v) { return __hip_atomic_fetch_add(p, v, __ATOMIC_RELAXED, __HIP_MEMORY_SCOPE_AGENT); }
__device__ __forceinline__ unsigned xb_xcc_id() { return (unsigned)__builtin_amdgcn_s_getreg((3 << 11) | 20) & 0xFu; }
#define XB_SPIN(cond, bar) do { unsigned _sp = 0; while (cond) { __builtin_amdgcn_s_sleep(1); \
    if ((++_sp & 255u) == 0u) { if (xb_ld(&(bar)[XB_TMO])) break; if (_sp > XB_SPIN_CAP) { atomicAdd(&(bar)[XB_TMO], 1u); break; } } } } while (0)
struct XcdBarrier { unsigned* bar; unsigned x; volatile LAS unsigned* st; };
__device__ __forceinline__ XcdBarrier xcd_barrier_post(unsigned* bar, volatile LAS unsigned* st) {
    XcdBarrier b; b.bar = bar; b.x = xb_xcc_id(); b.st = st;
    if (threadIdx.x == 0) (void)xb_add(&bar[XB_XCNT(b.x)], 1u);
    return b;
}
__device__ __forceinline__ void xcd_barrier_complete(unsigned* bar, unsigned x, unsigned& nloc, unsigned& nx) {
    const unsigned G = gridDim.x * gridDim.y * gridDim.z;
    unsigned sum, cnt, mine, sp = 0u;
    for (;;) {
        sum = 0u; cnt = 0u; mine = 0u;
#pragma unroll
        for (unsigned j = 0; j < 16; ++j) { const unsigned c = xb_ld(&bar[XB_XCNT(j)]); sum += c; cnt += (c > 0u) ? 1u : 0u; mine = (j == x) ? c : mine; }
        if (sum == G) break;
        __builtin_amdgcn_s_sleep(1);
        if ((++sp & 255u) == 0u) { if (xb_ld(&bar[XB_TMO])) break; if (sp > XB_SPIN_CAP) { atomicAdd(&bar[XB_TMO], 1u); break; } }
    }
    nloc = mine > 0u ? mine : 1u; nx = cnt > 0u ? cnt : 1u;
}
__device__ __forceinline__ void xcd_barrier(const XcdBarrier& b) {
    asm volatile("s_waitcnt vmcnt(0)" ::: "memory");
    __syncthreads();
    if (threadIdx.x == 0) {
        unsigned* bar = b.bar;
        __builtin_amdgcn_s_waitcnt(0);
        unsigned nloc = b.st[0], nx = b.st[1];
        if (nloc == 0u) { xcd_barrier_complete(bar, b.x, nloc, nx); b.st[0] = nloc; b.st[1] = nx; }
        const unsigned old = xb_add(&bar[XB_XSUB(b.x)], 1u);
        const unsigned gen = old / nloc;
        if (old + 1u == (gen + 1u) * nloc) {
            __builtin_amdgcn_fence(__ATOMIC_RELEASE, "agent");
            asm volatile("s_waitcnt vmcnt(0)" ::: "memory");
            const unsigned og = xb_add(&bar[XB_TOP], 1u);
            const unsigned tg = og / nx;
            if (og + 1u == (tg + 1u) * nx) xb_add(&bar[XB_TOPGEN], 1u);
            else XB_SPIN(xb_ld(&bar[XB_TOPGEN]) == tg, bar);
            __builtin_amdgcn_fence(__ATOMIC_ACQUIRE, "agent");
            xb_add(&bar[XB_XGEN(b.x)], 1u);
            asm volatile("s_waitcnt vmcnt(0)" ::: "memory");
        } else {
            XB_SPIN(xb_ld(&bar[XB_XGEN(b.x)]) == gen, bar);
            __builtin_amdgcn_fence(__ATOMIC_ACQUIRE, "agent");
            asm volatile("s_waitcnt vmcnt(0)" ::: "memory");
        }
    }
    __syncthreads();
}

__device__ __forceinline__ void phase_mod(const Params& p, int bid, int nblk, char* smem) {
    const int TIDX = otid();
    float* sc = (float*)smem;
    float* red = sc + 9 * 1024;
    const int tid = TIDX;
    for (int i = tid; i < 9 * 1024; i += NT) { const int v = i >> 10, k = i & 1023; const float cv = v < 8 ? p.c[v * 1024 + k] : p.c_ctx[k]; sc[i] = siluf(cv); }
    __syncthreads();
    for (int it = bid; it < 6144 / 32; it += nblk) {
        const int jj = tid & 31, ks = tid >> 5, j = it * 32 + jj;
        float acc[9];
#pragma unroll
        for (int v = 0; v < 9; ++v) acc[v] = 0.f;
#pragma unroll 16
        for (int k = ks * 64; k < ks * 64 + 64; ++k) {
            const float w = p.w_mod[(size_t)k * 6144 + j];
#pragma unroll
            for (int v = 0; v < 9; ++v) acc[v] += sc[v * 1024 + k] * w;
        }
#pragma unroll
        for (int v = 0; v < 9; ++v) red[(ks * 9 + v) * 32 + jj] = acc[v];
        __syncthreads();
        if (tid < 9 * 32) {
            const int v = tid >> 5; float s = 0.f;
            for (int q = 0; q < 16; ++q) s += red[(q * 9 + v) * 32 + jj];
            p.mod[v * 6144 + j] = s + p.b_mod[j];
        }
        __syncthreads();
    }
}

__device__ __forceinline__ void phase_modulate(const Params& p, int bid, int nblk) {
    const int TIDX = otid();
    const int lane = TIDX & 63;
    for (int row8 = (bid * 8 + (TIDX >> 6)) * 8; row8 < NTOK; row8 += nblk * 64) {
        const float* src; int v;
        if (row8 < NLAT) { src = p.x + (size_t)row8 * 1024; v = row8 / SEQ; } else { src = p.ctx + (size_t)(row8 - NLAT) * 1024; v = 8; }
        float4 xv[8][4];
#pragma unroll
        for (int r = 0; r < 8; ++r)
#pragma unroll
            for (int i = 0; i < 4; ++i) { const f32x4 t_ = __builtin_nontemporal_load((const f32x4*)(src + r * 1024 + i * 256 + lane * 4)); xv[r][i] = make_float4(t_[0], t_[1], t_[2], t_[3]); }
        const float* mv = p.mod + v * 6144;
        f32x4 gn[4], sh[4];
#pragma unroll
        for (int i = 0; i < 4; ++i) { const int k = i * 256 + lane * 4; gn[i] = *(const f32x4*)(p.norm_mix_pre + k); const f32x4 sc = *(const f32x4*)(mv + 1024 + k); sh[i] = *(const f32x4*)(mv + k); gn[i] *= (sc + 1.0f); }
#pragma unroll
        for (int r = 0; r < 8; ++r) {
            float ss = 0.f;
#pragma unroll
            for (int i = 0; i < 4; ++i) ss += xv[r][i].x * xv[r][i].x + xv[r][i].y * xv[r][i].y + xv[r][i].z * xv[r][i].z + xv[r][i].w * xv[r][i].w;
            ss = wave_sum(ss);
            const float rstd = rsqrtf(ss * (1.0f / 1024.0f) + RMS_EPS);
            float o[4][4]; float mx = 0.f;
#pragma unroll
            for (int i = 0; i < 4; ++i) {
                o[i][0] = xv[r][i].x * rstd * gn[i][0] + sh[i][0]; o[i][1] = xv[r][i].y * rstd * gn[i][1] + sh[i][1]; o[i][2] = xv[r][i].z * rstd * gn[i][2] + sh[i][2]; o[i][3] = xv[r][i].w * rstd * gn[i][3] + sh[i][3];
                mx = fmaxf(fmaxf(mx, fmaxf(fabsf(o[i][0]), fabsf(o[i][1]))), fmaxf(fabsf(o[i][2]), fabsf(o[i][3])));
            }
            mx = fmaxf(wave_max(mx), 1e-20f);
            const float inv = 127.0f * frcp(mx);
            if (lane == 0) p.hscale[row8 + r] = mx * (1.0f / 127.0f);
#pragma unroll
            for (int i = 0; i < 4; ++i) {
                const int q0 = (int)rintf(o[i][0] * inv), q1 = (int)rintf(o[i][1] * inv), q2 = (int)rintf(o[i][2] * inv), q3 = (int)rintf(o[i][3] * inv);
                *(unsigned*)(p.hq + (size_t)(row8 + r) * 1024 + i * 256 + lane * 4) = (unsigned)(q0 & 255) | ((unsigned)(q1 & 255) << 8) | ((unsigned)(q2 & 255) << 16) | ((unsigned)q3 << 24);
            }
        }
    }
}

struct TrTile { const float* src; bf16_t* dst; int lds_, k0, n0, nvalid, dr0, dc0; size_t ldd; const float* ksc; };
template <class Gen>
__device__ __forceinline__ void tr_stream(const Gen& gen, char* smem) {
    const int TIDX = otid();
    float* tile = (float*)smem;
    const int tid = TIDX, nl = tid & 127, kl = tid >> 7;
    TrTile t0, t1; float v0[16], v1[16];
    auto ld = [&](const TrTile& t, float (&v)[16]) {
#pragma unroll
        for (int i = 0; i < 16; ++i) v[i] = (t.n0 + nl < t.nvalid) ? t.src[(size_t)(t.k0 + kl + 4 * i) * t.lds_ + t.n0 + nl] * (t.ksc ? t.ksc[t.k0 + kl + 4 * i] : 1.0f) : 0.f;
    };
    auto emit = [&](const TrTile& c, const float (&v)[16], float* tb) {
#pragma unroll
        for (int i = 0; i < 16; ++i) tb[(kl + 4 * i) * 129 + nl] = v[i];
        __syncthreads();
#pragma unroll
        for (int i = 0; i < 8; ++i) { const int k2 = (tid & 31) * 2, n = (tid >> 5) + 16 * i;
            *(unsigned*)(c.dst + (size_t)(c.dr0 + n) * c.ldd + c.dc0 + k2) = g8::cvt_pk_bf16(tb[k2 * 129 + n], tb[(k2 + 1) * 129 + n]); }
    };
    bool h0 = gen(0, t0), h1 = gen(1, t1);
    if (h0) ld(t0, v0);
    if (h1) ld(t1, v1);
    for (int it = 0; h0; it += 2) {
        { const TrTile c = t0; emit(c, v0, tile); h0 = gen(it + 2, t0); if (h0) ld(t0, v0); }
        if (!h1) break;
        { const TrTile c = t1; emit(c, v1, tile + 64 * 129); h1 = gen(it + 3, t1); if (h1) ld(t1, v1); }
    }
    __syncthreads();
}
struct GenPrepQ { Params p; int bid, nblk;
    __device__ __forceinline__ bool operator()(int idx, int& kt, int& ntl) const { const int it = idx * nblk + bid; if (it >= 864) return false; kt = it & 15; ntl = it >> 4; return true; } };
__device__ __forceinline__ void tr_stream_q(const Params& p, int bid, int nblk, char* smem) {
    const int TIDX = otid();
    float* tile = (float*)smem;
    const int tid = TIDX, nl = tid & 127, kl = tid >> 7;
    GenPrepQ gen{p, bid, nblk};
    int kt0, nt0, kt1, nt1; float v0[16], v1[16];
    auto ld = [&](int kt, int ntl, float (&v)[16]) {
#pragma unroll
        for (int i = 0; i < 16; ++i) v[i] = (ntl * 128 + nl < P_IN) ? p.w_in[(size_t)(kt * 64 + kl + 4 * i) * P_IN + ntl * 128 + nl] : 0.f;
    };
    auto emit = [&](int kt, int ntl, const float (&v)[16], float* tb) {
#pragma unroll
        for (int i = 0; i < 16; ++i) tb[(kl + 4 * i) * 129 + nl] = v[i];
        __syncthreads();
#pragma unroll
        for (int i = 0; i < 4; ++i) { const int k4 = (tid & 15) * 4, n = (tid >> 4) + 32 * i, ng = ntl * 128 + n;
            const float cm = fmaxf(__uint_as_float(p.colmax[ng]), 1e-20f), inv = 127.0f * frcp(cm);
            const int q0 = (int)rintf(tb[k4 * 129 + n] * inv), q1 = (int)rintf(tb[(k4 + 1) * 129 + n] * inv), q2 = (int)rintf(tb[(k4 + 2) * 129 + n] * inv), q3 = (int)rintf(tb[(k4 + 3) * 129 + n] * inv);
            *(unsigned*)(p.WinQ + (size_t)ng * 1024 + kt * 64 + k4) = (unsigned)(q0 & 255) | ((unsigned)(q1 & 255) << 8) | ((unsigned)(q2 & 255) << 16) | ((unsigned)q3 << 24);
            if (kt == 0 && (tid & 15) == 0) p.wscale[ng] = cm * (1.0f / 127.0f); }
    };
    bool h0 = gen(0, kt0, nt0), h1 = gen(1, kt1, nt1);
    if (h0) ld(kt0, nt0, v0);
    if (h1) ld(kt1, nt1, v1);
    for (int it = 0; h0; it += 2) {
        { const int ck = kt0, cn = nt0; emit(ck, cn, v0, tile); h0 = gen(it + 2, kt0, nt0); if (h0) ld(kt0, nt0, v0); }
        if (!h1) break;
        { const int ck = kt1, cn = nt1; emit(ck, cn, v1, tile + 64 * 129); h1 = gen(it + 3, kt1, nt1); if (h1) ld(kt1, nt1, v1); }
    }
    __syncthreads();
}
__device__ __forceinline__ void phase_colmax(const Params& p, int bid, int nblk) {
    const int tid = otid();
    for (int it = bid; it < 128; it += nblk) {
        const float* base = p.w_in + (size_t)it * 8 * P_IN;
#pragma unroll 2
        for (int j = 0; j < 14; ++j) {
            const int n = tid + 512 * j;
            if (n < P_IN) {
                float m = 0.f;
#pragma unroll
                for (int r = 0; r < 8; ++r) m = fmaxf(m, fabsf(base[(size_t)r * P_IN + n]));
                atomicMax(p.colmax + n, __float_as_uint(m));
            }
        }
    }
}
struct GenPrepA { Params p; int bid, nblk;
    __device__ __forceinline__ bool operator()(int idx, TrTile& t) const {
        const int it = idx * nblk + bid + 864; if (it >= 864 + 192 + 128) return false;
        if (it < 1056) { const int j = it - 864, kt = j % 24, ntl = j / 24; t = TrTile{p.w_ssd_out, p.WmT, 1024, kt * 64, ntl * 128, 1024, ntl * 128, 1024 + kt * 64, AVLD, p.ssd_norm}; }
        else { const int j = it - 1056, kt = j & 15, ntl = j >> 4; t = TrTile{p.w_out, p.WoT, 1024, kt * 64, ntl * 128, 1024, ntl * 128, kt * 64, 1024, nullptr}; }
        return true;
    } };
__device__ __forceinline__ void phase_prep(const Params& p, int bid, int nblk, char* smem) {
    const int TIDX = otid();
    { GenPrepA g{p, bid, nblk}; tr_stream(g, smem); }
    const int tid = TIDX;
    if (bid >= 128 && bid - 128 < 128) {
        { const int it = bid - 128;
            const int idx = it * NT + tid, n = idx & 1023, g = (idx >> 10) & 3, c0 = (idx >> 12) * 8;
            float ac[8], as[8];
#pragma unroll
            for (int j = 0; j < 8; ++j) { ac[j] = 0.f; as[j] = 0.f; }
#pragma unroll 1
            for (int m0 = 0; m0 < 128; m0 += 32) {
                float wv[32];
#pragma unroll
                for (int mm = 0; mm < 32; ++mm) wv[mm] = p.w_fourier[(size_t)(g * 128 + m0 + mm) * 1024 + n];
#pragma unroll
                for (int mm = 0; mm < 32; ++mm) {
                    const int m = m0 + mm;
#pragma unroll
                    for (int j = 0; j < 8; ++j) { const float ph = (float)((m * (c0 + j)) & 127) * (1.0f / 128.0f); ac[j] += __builtin_amdgcn_cosf(ph) * wv[mm]; as[j] += __builtin_amdgcn_sinf(ph) * wv[mm]; }
                }
            }
            const float sN = 0.0013810679320049757f;
            unsigned wc_[4], ws_[4];
#pragma unroll
            for (int j = 0; j < 4; ++j) { wc_[j] = g8::cvt_pk_bf16(sN * ac[2 * j], sN * ac[2 * j + 1]); ws_[j] = g8::cvt_pk_bf16(-sN * as[2 * j], -sN * as[2 * j + 1]); }
            bf16_t* d0 = p.WmT + (size_t)n * AVLD + g * 128 + c0;
            *(u32x4*)d0 = (u32x4){wc_[0], wc_[1], wc_[2], wc_[3]};
            *(u32x4*)(d0 + 512) = (u32x4){ws_[0], ws_[1], ws_[2], ws_[3]};
        }
    }
    for (int it = bid; it < 2048; it += nblk) {
        {
            const int idx = it * NT + tid, r = idx >> 8, l0 = (idx & 255) * 8;
            const int rr = r & 2047, sh = r < 2048 ? 0 : 1024;
            unsigned w[4];
#pragma unroll
            for (int j = 0; j < 4; ++j) { const int ph0 = ((rr * (l0 + 2 * j)) - sh) & 4095, ph1 = ((rr * (l0 + 2 * j + 1)) - sh) & 4095;
                w[j] = g8::cvt_pk_bf16(__builtin_amdgcn_cosf((float)ph0 * (1.0f / 4096.0f)), __builtin_amdgcn_cosf((float)ph1 * (1.0f / 4096.0f))); }
            *(u32x4*)(p.dmat + (size_t)r * 2048 + l0) = (u32x4){w[0], w[1], w[2], w[3]};
        }
    }
}
struct TrTile8 { const float* src; unsigned char* dst; int k0, n0, dr0; };
template <class Gen>
__device__ __forceinline__ void tr_stream8(const Gen& gen, char* smem) {
    const int TIDX = otid();
    float* tile = (float*)smem;
    const int tid = TIDX, nl = tid & 127, kl = tid >> 7;
    TrTile8 t0, t1; float v0[16], v1[16];
    auto ld = [&](const TrTile8& t, float (&v)[16]) {
#pragma unroll
        for (int i = 0; i < 16; ++i) v[i] = __builtin_nontemporal_load(t.src + (size_t)(t.k0 + kl + 4 * i) * 1024 + t.n0 + nl);
    };
    auto emit = [&](const TrTile8& c, const float (&v)[16], float* tb) {
#pragma unroll
        for (int i = 0; i < 16; ++i) tb[(kl + 4 * i) * 129 + nl] = v[i];
        __syncthreads();
#pragma unroll
        for (int i = 0; i < 4; ++i) { const int k4 = (tid & 15) * 4, n = (tid >> 4) + 32 * i;
            int pk = __builtin_amdgcn_cvt_pk_fp8_f32(clamp8(64.f * tb[k4 * 129 + n]), clamp8(64.f * tb[(k4 + 1) * 129 + n]), 0, false);
            pk = __builtin_amdgcn_cvt_pk_fp8_f32(clamp8(64.f * tb[(k4 + 2) * 129 + n]), clamp8(64.f * tb[(k4 + 3) * 129 + n]), pk, true);
            *(int*)(c.dst + (size_t)(c.dr0 + n) * 1024 + c.k0 + k4) = pk; }
    };
    bool h0 = gen(0, t0), h1 = gen(1, t1);
    if (h0) ld(t0, v0);
    if (h1) ld(t1, v1);
    for (int it = 0; h0; it += 2) {
        { const TrTile8 c = t0; emit(c, v0, tile); h0 = gen(it + 2, t0); if (h0) ld(t0, v0); }
        if (!h1) break;
        { const TrTile8 c = t1; emit(c, v1, tile + 64 * 129); h1 = gen(it + 3, t1); if (h1) ld(t1, v1); }
    }
    __syncthreads();
}
struct GenPrepB8 { Params p; int bid, nblk, lo, hi;
    __device__ __forceinline__ bool operator()(int idx, TrTile8& t) const {
        const int it = lo + idx * nblk + bid; if (it >= hi) return false;
        const int which = it >> 11, j = it & 2047, e = j >> 7, kt = j & 15, ntl = (j >> 4) & 7, n0 = ntl * 128;
        if (which == 0) t = TrTile8{p.w_e_gate + (size_t)e * 1048576, p.WguT8, kt * 64, n0, e * 2048 + ntl * 256};
        else if (which == 1) t = TrTile8{p.w_e_up + (size_t)e * 1048576, p.WguT8, kt * 64, n0, e * 2048 + ntl * 256 + 128};
        else t = TrTile8{p.w_e_down + (size_t)e * 1048576, p.WdT8, kt * 64, n0, e * 1024 + n0};
        return true;
    } };
__device__ __forceinline__ void phase_prep2(const Params& p, int bid, int nblk, int lo, int hi, char* smem) {
    __syncthreads();
    GenPrepB8 g{p, bid, nblk, lo, hi}; tr_stream8(g, smem);
}
__device__ __forceinline__ u32x4 pack8(const f32x4 v0, const f32x4 v1) { return (u32x4){g8::cvt_pk_bf16(v0[0], v0[1]), g8::cvt_pk_bf16(v0[2], v0[3]), g8::cvt_pk_bf16(v1[0], v1[1]), g8::cvt_pk_bf16(v1[2], v1[3])}; }
__device__ __forceinline__ void unpack8(const u32x4 w, float (&o)[8]) {
#pragma unroll
    for (int j = 0; j < 4; ++j) { o[2 * j] = __uint_as_float(w[j] << 16); o[2 * j + 1] = __uint_as_float(w[j] & 0xffff0000u); }
}
struct SchedInProj { const char* A; const char* B; int G, c;
    __device__ __forceinline__ bool next(int i, g8::Unit& u) const {
        const int L = i * G + c; int pm, pn;
        if (L < 3456) g8::grid_map(L, 128, 27, pm, pn);
        else if (L < 3544) { const int L2 = L - 3456; pm = 128 + (L2 & 7); pn = 8 + (L2 >> 3); }
        else return false;
        u.A = A + (size_t)pm * 256 * 1024; u.B = B + (size_t)pn * 256 * 1024; u.gidx = nullptr; u.nt = 8; u.pm = pm; u.pn = pn; u.aux = 0;
        if (pn < 2) { const char* t = u.A; u.A = u.B; u.B = t; }
        return true;
    } };
__device__ __forceinline__ float dpp_ror1(float v) { return __int_as_float(__builtin_amdgcn_update_dpp(0, __float_as_int(v), 0x121, 0xF, 0xF, false)); }
__device__ __forceinline__ float dpp_ror15(float v) { return __int_as_float(__builtin_amdgcn_update_dpp(0, __float_as_int(v), 0x12F, 0xF, 0xF, false)); }
struct EpiInProj { static constexpr bool PERM = true; Params p; LAS unsigned char* lds;
    __device__ __forceinline__ bool operator()(f32x4 (&acc)[2][2][4][2], const g8::Unit& u, int wr, int wc, int fr, int fq) const {
        const int row0 = u.pm * 256 + wr * 64 + fr;
        {
            const bool sw = u.pn < 2;
            const float* rsc = sw ? p.wscale + u.pn * 256 + wr * 64 + fr : p.hscale + row0;
            const float* csc = sw ? p.hscale + u.pm * 256 + wc * 32 + fq * 8 : p.wscale + u.pn * 256 + wc * 32 + fq * 8;
            float sa[2][4];
#pragma unroll
            for (int ai = 0; ai < 2; ++ai)
#pragma unroll
                for (int m = 0; m < 4; ++m) sa[ai][m] = rsc[ai * 128 + m * 16];
#pragma unroll
            for (int bj = 0; bj < 2; ++bj) {
                const f32x4 s0 = *(const f32x4*)(csc + bj * 128), s1 = *(const f32x4*)(csc + bj * 128 + 4);
#pragma unroll
                for (int ai = 0; ai < 2; ++ai)
#pragma unroll
                    for (int m = 0; m < 4; ++m)
#pragma unroll
                        for (int j = 0; j < 4; ++j) { acc[ai][bj][m][0][j] = (float)__float_as_int(acc[ai][bj][m][0][j]) * (sa[ai][m] * s0[j]); acc[ai][bj][m][1][j] = (float)__float_as_int(acc[ai][bj][m][1][j]) * (sa[ai][m] * s1[j]); }
            }
        }
        if (u.pn < 2) {
            bf16_t* base = p.ufT + (size_t)((u.pm >> 4) * 512 + u.pn * 256 + wr * 64 + fr) * 4096 + (u.pm & 15) * 256 + wc * 32 + fq * 8;
#pragma unroll
            for (int ai = 0; ai < 2; ++ai)
#pragma unroll
                for (int m = 0; m < 4; ++m)
#pragma unroll
                    for (int bj = 0; bj < 2; ++bj) *(u32x4*)(base + (size_t)(ai * 128 + m * 16) * 4096 + bj * 128) = pack8(acc[ai][bj][m][0], acc[ai][bj][m][1]);
            return false;
        }
        if (u.pn >= 8 && u.pn < 18 && u.pm < 128) {
#pragma unroll
            for (int bj = 0; bj < 2; ++bj) {
                const int ch0 = u.pn * 256 + bj * 128 + wc * 32 + fq * 8 - 2048;
                float cwv[8][4];
#pragma unroll
                for (int i = 0; i < 4; ++i) { const u32x4 tv = *(const LAS u32x4*)(lds + CONVT_OFF + ch0 * 8 + 16 * i);
                    cwv[2 * i][0] = __uint_as_float(tv[0] << 16); cwv[2 * i][1] = __uint_as_float(tv[0] & 0xffff0000u); cwv[2 * i][2] = __uint_as_float(tv[1] << 16); cwv[2 * i][3] = __uint_as_float(tv[1] & 0xffff0000u);
                    cwv[2 * i + 1][0] = __uint_as_float(tv[2] << 16); cwv[2 * i + 1][1] = __uint_as_float(tv[2] & 0xffff0000u); cwv[2 * i + 1][2] = __uint_as_float(tv[3] << 16); cwv[2 * i + 1][3] = __uint_as_float(tv[3] & 0xffff0000u); }
#pragma unroll
                for (int ai = 0; ai < 2; ++ai) {
                    unsigned pk[4][4];
#pragma unroll
                    for (int jp = 0; jp < 4; ++jp) {
                        float o[4][2];
#pragma unroll
                        for (int h = 0; h < 2; ++h) {
                            const int j = 2 * jp + h;
                            const float w0 = cwv[j][0], w1 = cwv[j][1], w2 = cwv[j][2], bb = cwv[j][3];
                            float uu[4], r1[4], l1[4];
#pragma unroll
                            for (int m = 0; m < 4; ++m) { uu[m] = acc[ai][bj][m][j >> 2][j & 3]; r1[m] = dpp_ror1(uu[m]); l1[m] = dpp_ror15(uu[m]); }
#pragma unroll
                            for (int m = 0; m < 4; ++m) {
                                const float up = fr > 0 ? r1[m] : (m > 0 ? r1[m > 0 ? m - 1 : 0] : 0.f);
                                const float dn = fr < 15 ? l1[m] : (m < 3 ? l1[m < 3 ? m + 1 : 3] : 0.f);
                                o[m][h] = siluf(w0 * up + w1 * uu[m] + w2 * dn + bb);
                            }
                        }
#pragma unroll
                        for (int m = 0; m < 4; ++m) pk[m][jp] = g8::cvt_pk_bf16(o[m][0], o[m][1]);
                    }
#pragma unroll
                    for (int m = 0; m < 4; ++m) *(u32x4*)(p.xbc + (size_t)(row0 + ai * 128 + m * 16) * CONV_CH + ch0) = (u32x4){pk[m][0], pk[m][1], pk[m][2], pk[m][3]};
                }
                asm volatile("" ::: "memory");
            }
            return false;
        }
#pragma unroll
        for (int bj = 0; bj < 2; ++bj) {
            const int n0 = u.pn * 256 + bj * 128 + wc * 32 + fq * 8;
            if (n0 >= 4608 && n0 < 4656) {
#pragma unroll
                for (int ai = 0; ai < 2; ++ai)
#pragma unroll
                    for (int m = 0; m < 4; ++m) { float* q = p.dtraw + (size_t)(row0 + ai * 128 + m * 16) * 48 + (n0 - 4608); *(f32x4*)q = acc[ai][bj][m][0]; *(f32x4*)(q + 4) = acc[ai][bj][m][1]; }
            } else if (n0 < P_IN) {
                auto st = [&](bf16_t* base, size_t ld) {
#pragma unroll
                    for (int ai = 0; ai < 2; ++ai)
#pragma unroll
                        for (int m = 0; m < 4; ++m) *(u32x4*)(base + (size_t)(row0 + ai * 128 + m * 16) * ld) = pack8(acc[ai][bj][m][0], acc[ai][bj][m][1]);
                };
                if (n0 < 2048) { if (u.pm < 128) st(p.z + (n0 - 512), 1536); }
                else if (n0 < 4608) st(p.xbc + (n0 - 2048), 2560);
                else if (u.pm < 128) {
                    const int gcol = n0 - 4656, br = gcol >> 10, c8 = (gcol & 1023) >> 3;
                    const f32x4 b0 = *(const f32x4*)(p.b_gate + gcol), b1 = *(const f32x4*)(p.b_gate + gcol + 4);
#pragma unroll
                    for (int ai = 0; ai < 2; ++ai)
#pragma unroll
                        for (int m = 0; m < 4; ++m) {
                            unsigned w0 = 0, w1 = 0;
#pragma unroll
                            for (int j = 0; j < 4; ++j) { w0 |= (unsigned)__builtin_rintf(255.0f * sigmoidf(acc[ai][bj][m][0][j] + b0[j])) << (8 * j); w1 |= (unsigned)__builtin_rintf(255.0f * sigmoidf(acc[ai][bj][m][1][j] + b1[j])) << (8 * j); }
                            *(u32x2*)(p.gq + (size_t)(row0 + ai * 128 + m * 16) * 2048 + c8 * 16 + br * 8) = (u32x2){w0, w1};
                        }
                }
            }
        }
        return false;
    } };
struct SchedDft { const char* A; const char* Be; const char* Bo; int c;
    __device__ __forceinline__ bool next(int i, g8::Unit& u) const {
        if (c < 0 || i >= 4) return false;
        const int pn = c >> 2, q = c & 3, pm = 4 * q + i;
        u.A = A + (size_t)pm * 256 * 4096; u.B = (q < 2 ? Be : Bo) + (size_t)pn * 256 * 4096; u.gidx = nullptr; u.nt = 32; u.pm = pm; u.pn = pn; u.aux = 0; return true;
    } };
struct EpiDft { static constexpr bool PERM = true; Params p;
    __device__ __forceinline__ bool operator()(const f32x4 (&acc)[2][2][4][2], const g8::Unit& u, int wr, int wc, int fr, int fq) const {
        const int b = u.pn >> 1;
        const u32x4 zero4 = (u32x4){0u, 0u, 0u, 0u};
#pragma unroll
        for (int bj = 0; bj < 2; ++bj) {
            const int ch0 = (u.pn & 1) * 256 + bj * 128 + wc * 32 + fq * 8, col = u.pn * 256 + bj * 128 + wc * 32 + fq * 8;
            bf16_t* vb = p.av + (size_t)b * 4096 * AVLD + ch0;
            f32x4 um0 = (f32x4){0.f, 0.f, 0.f, 0.f}, um1 = um0;
            if (u.pm < 8) { um0 = *(const f32x4*)(p.umid + col); um1 = *(const f32x4*)(p.umid + col + 4); }
#pragma unroll
            for (int ai = 0; ai < 2; ++ai)
#pragma unroll
                for (int m = 0; m < 4; ++m) {
                    const int r = u.pm * 256 + ai * 128 + wr * 64 + m * 16 + fr;
                    const f32x4 v0 = acc[ai][bj][m][0], v1 = acc[ai][bj][m][1];
                    if (r < 2048) {
                        const float sg = (r & 1) ? -1.0f : 1.0f;
                        const u32x4 w = pack8(v0 + sg * um0, v1 + sg * um1);
                        *(u32x4*)(vb + (size_t)r * AVLD) = w;
                        if (r >= 1) *(u32x4*)(vb + (size_t)(4096 - r) * AVLD) = w;
                        if (r == 0) {
                            const f32x4 a0 = *(const f32x4*)(p.ualt + col), a1 = *(const f32x4*)(p.ualt + col + 4);
                            *(u32x4*)(vb + (size_t)2048 * AVLD) = pack8(a0, a1);
                            *(u32x4*)(vb + (size_t)2048 * AVLD + 512) = zero4;
                        }
                    } else {
                        const int k = r - 2048;
                        *(u32x4*)(vb + (size_t)k * AVLD + 512) = pack8(v0, v1);
                        if (k >= 1) *(u32x4*)(vb + (size_t)(4096 - k) * AVLD + 512) = pack8(-v0, -v1);
                    }
                }
        }
        return false;
    } };
__device__ __forceinline__ void dft_evenodd(const Params& p, int c) {
    const int tid = otid(), lane = tid & 63, wv = tid >> 6, pn = c >> 2; const bool odd = (c & 3) >= 2;
    for (int rr = 0; rr < 32; ++rr) {
        const int row = pn * 256 + wv * 32 + rr;
        const bf16_t* u = p.ufT + (size_t)row * 4096;
        bf16_t* dst = (odd ? p.uoT : p.ueT) + (size_t)row * 2048;
        float alt = 0.f;
#pragma unroll
        for (int ci = 0; ci < 4; ++ci) {
            const int jc = lane + 64 * ci;
            float d[8], ma[8], mb[8];
            unpack8(*(const u32x4*)(u + 8 * jc), d);
            unpack8(*(const u32x4*)(u + 4088 - 8 * jc), ma);
            unpack8(jc ? *(const u32x4*)(u + 4096 - 8 * jc) : (u32x4){0u, 0u, 0u, 0u}, mb);
            float o[8];
            o[0] = odd ? (jc ? d[0] - mb[0] : 0.f) : d[0] + mb[0];
#pragma unroll
            for (int i = 1; i < 8; ++i) o[i] = odd ? d[i] - ma[8 - i] : d[i] + ma[8 - i];
            *(u32x4*)(dst + 8 * jc) = (u32x4){g8::cvt_pk_bf16(o[0], o[1]), g8::cvt_pk_bf16(o[2], o[3]), g8::cvt_pk_bf16(o[4], o[5]), g8::cvt_pk_bf16(o[6], o[7])};
            alt += ((o[0] - o[1]) + (o[2] - o[3])) + ((o[4] - o[5]) + (o[6] - o[7]));
        }
        if (!odd) {
            alt = wave_sum(alt);
            const float mid = bf2f(u[2048]);
            if (lane == 0) { p.umid[row] = mid; p.ualt[row] = alt + mid; }
        }
    }
    asm volatile("s_waitcnt vmcnt(0)" ::: "memory");
    __syncthreads();
}
struct SchedMerged { const char* A; const char* B; int G, c;
    __device__ __forceinline__ bool next(int i, g8::Unit& u) const {
        const int L = (i >> 1) * G + c; if (L >= 512) return false; int pm, pn; g8::grid_map(L, 128, 4, pm, pn); const int seg = i & 1;
        u.A = A + (size_t)pm * 256 * (AVLD * 2) + (seg ? 0 : 2048); u.B = B + (size_t)pn * 256 * (AVLD * 2) + (seg ? 0 : 2048);
        u.gidx = nullptr; u.nt = seg ? 16 : 24; u.pm = pm; u.pn = pn; u.aux = seg | ((i >> 1) << 1); return true;
    } };
struct EpiMerged { static constexpr bool PERM = true; Params p; LAS unsigned char* lds;
    __device__ __forceinline__ bool operator()(f32x4 (&acc)[2][2][4][2], const g8::Unit& u, int wr, int wc, int fr, int fq) const {
        const int row0 = u.pm * 256 + wr * 64 + fr, seg = u.aux & 1;
        const LAS float* rs = (const LAS float*)(lds + MERGED_RS_OFF) + (u.aux >> 1) * 256 + wr * 64 + fr;
#pragma unroll
        for (int bj = 0; bj < 2; ++bj) {
            const int c0 = u.pn * 256 + bj * 128 + wc * 32 + fq * 8;
            const int c8 = (u.pn * 256 + bj * 128 + wc * 32 + fq * 8) >> 3;
#pragma unroll
            for (int ai = 0; ai < 2; ++ai) {
                u32x4 gv[4];
#pragma unroll
                for (int m = 0; m < 4; ++m) gv[m] = *(const u32x4*)(p.gq + (size_t)(row0 + ai * 128 + m * 16) * 2048 + c8 * 16);
#pragma unroll
                for (int m = 0; m < 4; ++m) {
                    const size_t row = (size_t)(row0 + ai * 128 + m * 16);
                    float g0[8], g1[8];
#pragma unroll
                    for (int j = 0; j < 4; ++j) { g0[j] = fmaxf((float)((gv[m][0] >> (8 * j)) & 255u), 1.0f) * (1.0f / 255.0f); g0[4 + j] = fmaxf((float)((gv[m][1] >> (8 * j)) & 255u), 1.0f) * (1.0f / 255.0f);
                                                  g1[j] = (float)((gv[m][2] >> (8 * j)) & 255u) * (1.0f / 255.0f); g1[4 + j] = (float)((gv[m][3] >> (8 * j)) & 255u) * (1.0f / 255.0f); }
                    if (seg == 0) {
                        const float rstd = rs[ai * 128 + m * 16];
#pragma unroll
                        for (int j = 0; j < 8; ++j) acc[ai][bj][m][j >> 2][j & 3] *= rstd * g1[j] * frcp(g0[j]);
                    } else {
                        f32x4 v0 = acc[ai][bj][m][0], v1 = acc[ai][bj][m][1];
#pragma unroll
                        for (int j = 0; j < 4; ++j) { v0[j] *= g0[j]; v1[j] *= g0[4 + j]; }
                        *(u32x4*)(p.merged + row * 1024 + c0) = pack8(v0, v1);
                    }
                }
                asm volatile("" ::: "memory");
            }
        }
        return seg == 0;
    } };
__device__ __forceinline__ void merged_prologue(const Params& p, int bid, int nblk, LAS unsigned char* lds) {
    const int tid = otid(), slot = tid >> 8, rl = tid & 255, L = slot * nblk + bid;
    if (L < 512) {
        int pm, pn; g8::grid_map(L, 128, 4, pm, pn);
        const f32x4* q4 = (const f32x4*)(p.ssq + (size_t)(pm * 256 + rl) * NHEADS);
        float sum = 0.f;
#pragma unroll
        for (int i = 0; i < 6; ++i) { const f32x4 v = q4[i]; sum += (v[0] + v[1]) + (v[2] + v[3]); }
        ((LAS float*)(lds + MERGED_RS_OFF))[slot * 256 + rl] = rsqrtf(sum * (1.0f / D_INNER) + RMS_EPS);
    }
    __syncthreads();
}
struct SchedWOut { const char* A; const char* B; int G, c;
    __device__ __forceinline__ bool next(int i, g8::Unit& u) const {
        const int L = i * G + c; if (L >= 512) return false; int pm, pn; g8::grid_map(L, 128, 4, pm, pn);
        u.A = A + (size_t)pm * 256 * 2048; u.B = B + (size_t)pn * 256 * 2048; u.gidx = nullptr; u.nt = 16; u.pm = pm; u.pn = pn; u.aux = 0; return true;
    } };
struct EpiWOut { static constexpr bool PERM = true; Params p;
    __device__ __forceinline__ bool operator()(const f32x4 (&acc)[2][2][4][2], const g8::Unit& u, int wr, int wc, int fr, int fq) const {
        const int row0 = u.pm * 256 + wr * 64 + fr;
#pragma unroll
        for (int ai = 0; ai < 2; ++ai)
#pragma unroll
            for (int m = 0; m < 4; ++m)
#pragma unroll
                for (int bj = 0; bj < 2; ++bj) *(u32x4*)(p.mix + (size_t)(row0 + ai * 128 + m * 16) * 1024 + u.pn * 256 + bj * 128 + wc * 32 + fq * 8) = pack8(acc[ai][bj][m][0], acc[ai][bj][m][1]);
        return false;
    } };
struct SchedExpUp { const char* A; const char* B; const int* topidx; int G, c;
    __device__ __forceinline__ bool next(int i, g8::Unit& u) const {
        const int L = i * G + c; if (L >= 2048) return false;
        const int e = L >> 7, pn = (L >> 4) & 7, rm = L & 15, b = rm >> 1, pml = rm & 1, be = b * 16 + e;
        u.A = A + (size_t)b * 4096 * 1024; u.B = B + ((size_t)e * 2048 + pn * 256) * 1024; u.gidx = topidx + be * CAP + pml * 256; u.nt = 8; u.pm = be * 2 + pml; u.pn = pn; u.aux = 0; return true;
    } };
struct EpiExpUp { static constexpr bool PERM = true; static constexpr int SCALE_A = 0x7F7F7F7F, SCALE_B = 0x79797979; Params p;
    __device__ __forceinline__ bool operator()(const f32x4 (&acc)[2][2][4][2], const g8::Unit& u, int wr, int wc, int fr, int fq) const {
        const int row0 = u.pm * 256 + wr * 64 + fr;
#pragma unroll
        for (int ai = 0; ai < 2; ++ai)
#pragma unroll
            for (int m = 0; m < 4; ++m) {
                float v[8];
#pragma unroll
                for (int j = 0; j < 8; ++j) v[j] = clamp8(4.0f * siluf(acc[ai][0][m][j >> 2][j & 3]) * acc[ai][1][m][j >> 2][j & 3]);
                int p0 = __builtin_amdgcn_cvt_pk_fp8_f32(v[0], v[1], 0, false); p0 = __builtin_amdgcn_cvt_pk_fp8_f32(v[2], v[3], p0, true);
                int p1 = __builtin_amdgcn_cvt_pk_fp8_f32(v[4], v[5], 0, false); p1 = __builtin_amdgcn_cvt_pk_fp8_f32(v[6], v[7], p1, true);
                *(u32x2*)(p.hid8 + (size_t)(row0 + ai * 128 + m * 16) * 1024 + u.pn * 128 + wc * 32 + fq * 8) = (u32x2){(unsigned)p0, (unsigned)p1};
            }
        return false;
    } };
struct SchedExpDown { const char* A; const char* B; int G, c;
    __device__ __forceinline__ bool next(int i, g8::Unit& u) const {
        const int L = i * G + c; if (L >= 1024) return false;
        const int e = L >> 6, pn = (L >> 4) & 3, rm = L & 15, b = rm >> 1, pml = rm & 1, be = b * 16 + e;
        u.A = A + ((size_t)be * CAP + pml * 256) * 1024; u.B = B + ((size_t)e * 1024 + pn * 256) * 1024; u.gidx = nullptr; u.nt = 8; u.pm = be * 2 + pml; u.pn = pn; u.aux = 0; return true;
    } };
struct EpiExpDown { static constexpr bool PERM = true; static constexpr int SCALE_A = 0x7D7D7D7D, SCALE_B = 0x79797979; Params p;
    __device__ __forceinline__ bool operator()(const f32x4 (&acc)[2][2][4][2], const g8::Unit& u, int wr, int wc, int fr, int fq) const {
        const int row0 = u.pm * 256 + wr * 64 + fr;
#pragma unroll
        for (int ai = 0; ai < 2; ++ai)
#pragma unroll
            for (int m = 0; m < 4; ++m) {
                const int row = row0 + ai * 128 + m * 16; const float ta = p.topaff[row];
#pragma unroll
                for (int bj = 0; bj < 2; ++bj) *(u32x4*)(p.ye + (size_t)row * 1024 + u.pn * 256 + bj * 128 + wc * 32 + fq * 8) = pack8(acc[ai][bj][m][0] * ta, acc[ai][bj][m][1] * ta);
            }
        return false;
    } };

#define SSD_BN 0
#define SSD_CN 16384
#define SSD_XN 32768
#define SSD_HN 40960
#define SSD_VEC 73728
#define SSD_DIRSZ 76800
typedef short s16x4 __attribute__((ext_vector_type(4)));
__device__ __forceinline__ unsigned ssd_offb(int row, int ch) { return 256u * (unsigned)row + 16u * (unsigned)(ch ^ (((row & 3) << 2) | ((row >> 2) & 3))); }
__device__ __forceinline__ unsigned ssd_offx(int row, int seg) { return 128u * (unsigned)row + 32u * (unsigned)(seg ^ ((row >> 1) & 3)); }
__device__ __forceinline__ s16x4 ssd_tr(unsigned addr) { s16x4 r; asm volatile("ds_read_b64_tr_b16 %0, %1" : "=&v"(r) : "v"(addr) : "memory"); return r; }
__device__ __forceinline__ float bfu(short v) { return __uint_as_float(((unsigned)(unsigned short)v) << 16); }
__device__ __forceinline__ bf16x8 ssd_pack8(const float (&m)[8]) {
    union { u32x4 u; bf16x8 b; } cv; cv.u = (u32x4){g8::cvt_pk_bf16(m[0], m[1]), g8::cvt_pk_bf16(m[2], m[3]), g8::cvt_pk_bf16(m[4], m[5]), g8::cvt_pk_bf16(m[6], m[7])}; return cv.b;
}
__device__ __forceinline__ void phase_ssd(const Params& p, int bid, int nblk, char* smem) {
    if (bid >= 192) return;
    const int tid = otid(), lane = tid & 63, wid = __builtin_amdgcn_readfirstlane(tid >> 6), dir = wid >> 2, w = wid & 3;
    const int gt = tid & 255, q = lane >> 4, L = lane & 15;
    const int b = bid & 7, head = bid >> 3, g = head / 6;
    LAS unsigned char* lds = (LAS unsigned char*)smem + dir * SSD_DIRSZ;
    const unsigned ldsa = (unsigned)(size_t)lds;
    const unsigned stB = ssd_offb(gt >> 4, gt & 15);
    const unsigned stX = ssd_offx(gt >> 3, (gt & 7) >> 1) + 16u * (gt & 1);
    unsigned rk[4], xa[4], ba[2], hw[2];
#pragma unroll
    for (int kn = 0; kn < 4; ++kn) rk[kn] = ssd_offb(L, 4 * kn + q);
#pragma unroll
    for (int pt = 0; pt < 4; ++pt) xa[pt] = ldsa + SSD_XN + ssd_offx(4 * q + (L >> 2), pt) + 8 * (L & 3);
#pragma unroll
    for (int nt = 0; nt < 2; ++nt) { ba[nt] = ldsa + SSD_BN + ssd_offb(4 * q + (L >> 2), 4 * w + 2 * nt + ((L & 3) >> 1)) + 8 * (L & 1);
                                     hw[nt] = ssd_offb(L, 4 * w + 2 * nt + (q >> 1)) + 8 * (q & 1); }
    asm volatile("" : "+v"(rk[0]), "+v"(rk[1]), "+v"(rk[2]), "+v"(rk[3]), "+v"(xa[0]), "+v"(xa[1]), "+v"(xa[2]), "+v"(xa[3]));
    asm volatile("" : "+v"(ba[0]), "+v"(ba[1]), "+v"(hw[0]), "+v"(hw[1]));
    LAS float* vec = (LAS float*)(lds + SSD_VEC + w * 768);
    const float a_ = -__expf(p.a_log[dir * NHEADS + head]), dtb = p.dt_bias[dir * NHEADS + head], dsk = p.d_skip[head];
    for (int i = gt; i < 1024; i += 256) *(LAS u32x4*)(lds + SSD_HN + i * 16) = (u32x4){0u, 0u, 0u, 0u};
    f32x4 Hacc[2][4];
#pragma unroll
    for (int i = 0; i < 2; ++i)
#pragma unroll
        for (int j = 0; j < 4; ++j) Hacc[i][j] = (f32x4){0.f, 0.f, 0.f, 0.f};
    u32x4 pb[4], pc[4], px[2]; float pdt;
    bf16x8 Xf[4][2];
    int cur = 0;
    auto do_vec = [&]() -> float {
        const float v = pdt + dtb; const float ev = __expf(v); const float dtv = v > 20.f ? v : (v < -15.f ? ev : __logf(1.0f + ev));
        const float da = dtv * a_;
        float ac = da;
        ac += __int_as_float(__builtin_amdgcn_update_dpp(0, __float_as_int(ac), 0x111, 0xF, 0xF, false));
        ac += __int_as_float(__builtin_amdgcn_update_dpp(0, __float_as_int(ac), 0x112, 0xF, 0xF, false));
        ac += __int_as_float(__builtin_amdgcn_update_dpp(0, __float_as_int(ac), 0x114, 0xF, 0xF, false));
        ac += __int_as_float(__builtin_amdgcn_update_dpp(0, __float_as_int(ac), 0x118, 0xF, 0xF, false));
        ac += __int_as_float(__builtin_amdgcn_update_dpp(0, __float_as_int(ac), 0x142, 0xA, 0xF, false));
        ac += __int_as_float(__builtin_amdgcn_update_dpp(0, __float_as_int(ac), 0x143, 0xC, 0xF, false));
        const float tot = __int_as_float(__builtin_amdgcn_readlane(__float_as_int(ac), 63));
        if (dir != 0) ac = tot - ac + da;
        const float aend = tot;
        vec[lane] = ac; vec[64 + lane] = dtv; vec[128 + lane] = __expf(fminf(aend - ac, 0.f)) * dtv;
        return __expf(aend);
    };
    auto prefetch = [&](int ci) {
        const int r1 = b * SEQ + ci * 64;
        int gl = gt; asm volatile("" : "+v"(gl));
        const bf16_t* rb = p.xbc + (size_t)r1 * CONV_CH;
#pragma unroll
        for (int i = 0; i < 4; ++i) { const int q_ = gl + 256 * i, row = q_ >> 4, ch = q_ & 15; pb[i] = *(const u32x4*)(rb + (size_t)row * CONV_CH + 1536 + g * 128 + ch * 8); pc[i] = *(const u32x4*)(rb + (size_t)row * CONV_CH + 2048 + g * 128 + ch * 8); }
#pragma unroll
        for (int i = 0; i < 2; ++i) { const int q_ = gl + 256 * i, row = q_ >> 3, c8 = q_ & 7; px[i] = *(const u32x4*)(rb + (size_t)row * CONV_CH + head * 64 + c8 * 8); }
        pdt = p.dtraw[(size_t)(r1 + (gl & 63)) * 48 + dir * NHEADS + head];
    };
    auto load_xf = [&]() {
        s16x4 lo[8], hi[8];
        asm volatile("ds_read_b64_tr_b16 %0, %16\n\tds_read_b64_tr_b16 %8, %16 offset:2048\n\t"
                     "ds_read_b64_tr_b16 %1, %17\n\tds_read_b64_tr_b16 %9, %17 offset:2048\n\t"
                     "ds_read_b64_tr_b16 %2, %18\n\tds_read_b64_tr_b16 %10, %18 offset:2048\n\t"
                     "ds_read_b64_tr_b16 %3, %19\n\tds_read_b64_tr_b16 %11, %19 offset:2048\n\t"
                     "ds_read_b64_tr_b16 %4, %16 offset:4096\n\tds_read_b64_tr_b16 %12, %16 offset:6144\n\t"
                     "ds_read_b64_tr_b16 %5, %17 offset:4096\n\tds_read_b64_tr_b16 %13, %17 offset:6144\n\t"
                     "ds_read_b64_tr_b16 %6, %18 offset:4096\n\tds_read_b64_tr_b16 %14, %18 offset:6144\n\t"
                     "ds_read_b64_tr_b16 %7, %19 offset:4096\n\tds_read_b64_tr_b16 %15, %19 offset:6144\n\t"
                     "s_waitcnt lgkmcnt(0)"
                     : "=&v"(lo[0]), "=&v"(lo[1]), "=&v"(lo[2]), "=&v"(lo[3]), "=&v"(lo[4]), "=&v"(lo[5]), "=&v"(lo[6]), "=&v"(lo[7]),
                       "=&v"(hi[0]), "=&v"(hi[1]), "=&v"(hi[2]), "=&v"(hi[3]), "=&v"(hi[4]), "=&v"(hi[5]), "=&v"(hi[6]), "=&v"(hi[7])
                     : "v"(xa[0]), "v"(xa[1]), "v"(xa[2]), "v"(xa[3]) : "memory");
#pragma unroll
        for (int kk = 0; kk < 2; ++kk)
#pragma unroll
            for (int pt = 0; pt < 4; ++pt) Xf[pt][kk] = __builtin_shufflevector(lo[4 * kk + pt], hi[4 * kk + pt], 0, 1, 2, 3, 4, 5, 6, 7);
    };
    auto do_state = [&](float dec) {
#pragma unroll
        for (int nt = 0; nt < 2; ++nt)
#pragma unroll
            for (int pt = 0; pt < 4; ++pt) Hacc[nt][pt] *= dec;
        s16x4 lo[2][2], hi[2][2];
        asm volatile("ds_read_b64_tr_b16 %0, %8\n\tds_read_b64_tr_b16 %4, %8 offset:4096\n\t"
                     "ds_read_b64_tr_b16 %1, %9\n\tds_read_b64_tr_b16 %5, %9 offset:4096\n\t"
                     "ds_read_b64_tr_b16 %2, %8 offset:8192\n\tds_read_b64_tr_b16 %6, %8 offset:12288\n\t"
                     "ds_read_b64_tr_b16 %3, %9 offset:8192\n\tds_read_b64_tr_b16 %7, %9 offset:12288\n\t"
                     "s_waitcnt lgkmcnt(0)"
                     : "=&v"(lo[0][0]), "=&v"(lo[0][1]), "=&v"(lo[1][0]), "=&v"(lo[1][1]), "=&v"(hi[0][0]), "=&v"(hi[0][1]), "=&v"(hi[1][0]), "=&v"(hi[1][1])
                     : "v"(ba[0]), "v"(ba[1]) : "memory");
#pragma unroll
        for (int kk = 0; kk < 2; ++kk) {
            const f32x4 wlo = *(const LAS f32x4*)(vec + 128 + 32 * kk + 4 * q), whi = *(const LAS f32x4*)(vec + 128 + 32 * kk + 16 + 4 * q);
#pragma unroll
            for (int nt = 0; nt < 2; ++nt) {
                float m[8];
#pragma unroll
                for (int r = 0; r < 4; ++r) { m[r] = bfu(lo[kk][nt][r]) * wlo[r]; m[4 + r] = bfu(hi[kk][nt][r]) * whi[r]; }
                const bf16x8 Bw = ssd_pack8(m);
#pragma unroll
                for (int pt = 0; pt < 4; ++pt) Hacc[nt][pt] = __builtin_amdgcn_mfma_f32_16x16x32_bf16(Bw, Xf[pt][kk], Hacc[nt][pt], 0, 0, 0);
            }
        }
#pragma unroll
        for (int nt = 0; nt < 2; ++nt)
#pragma unroll
            for (int pt = 0; pt < 4; ++pt)
                *(LAS u32x2*)(lds + SSD_HN + (cur ^ 1) * 16384 + pt * 4096 + hw[nt]) = (u32x2){g8::cvt_pk_bf16(Hacc[nt][pt][0], Hacc[nt][pt][1]), g8::cvt_pk_bf16(Hacc[nt][pt][2], Hacc[nt][pt][3])};
    };
    pdt = p.dtraw[(size_t)(NLAT + b * 256 + (dir ? 3 : 0) * 64 + lane) * 48 + dir * NHEADS + head];
#pragma unroll 1
    for (int k = 0; k < 4; ++k) {
        const int cidx = dir ? 3 - k : k;
        auto conv8 = [&](int tg, int ch) -> u32x4 {
            const bf16_t* rp = p.xbc + (size_t)(NLAT + b * 256 + tg) * CONV_CH + ch;
            float c_[8], p_[8], n_[8], o_[8];
            unpack8(*(const u32x4*)rp, c_);
            unpack8(tg > 0 ? *(const u32x4*)(rp - CONV_CH) : (u32x4){0u, 0u, 0u, 0u}, p_);
            unpack8(tg < 255 ? *(const u32x4*)(rp + CONV_CH) : (u32x4){0u, 0u, 0u, 0u}, n_);
#pragma unroll
            for (int h = 0; h < 2; ++h) {
                const f32x4 t0 = *(const f32x4*)(p.conv_w + ch + 4 * h), t1 = *(const f32x4*)(p.conv_w + CONV_CH + ch + 4 * h), t2 = *(const f32x4*)(p.conv_w + 2 * CONV_CH + ch + 4 * h), t3 = *(const f32x4*)(p.conv_b + ch + 4 * h);
#pragma unroll
                for (int j = 0; j < 4; ++j) o_[4 * h + j] = siluf(t0[j] * p_[4 * h + j] + t1[j] * c_[4 * h + j] + t2[j] * n_[4 * h + j] + t3[j]);
            }
            return (u32x4){g8::cvt_pk_bf16(o_[0], o_[1]), g8::cvt_pk_bf16(o_[2], o_[3]), g8::cvt_pk_bf16(o_[4], o_[5]), g8::cvt_pk_bf16(o_[6], o_[7])};
        };
#pragma unroll 1
        for (int i = 0; i < 4; ++i) { const int q_ = gt + 256 * i, row = q_ >> 4, ch = q_ & 15;
            *(LAS u32x4*)(lds + SSD_BN + 4096 * i + stB) = conv8(cidx * 64 + row, 1536 + g * 128 + ch * 8); *(LAS u32x4*)(lds + SSD_CN + 4096 * i + stB) = conv8(cidx * 64 + row, 2048 + g * 128 + ch * 8); }
#pragma unroll 1
        for (int i = 0; i < 2; ++i) { const int q_ = gt + 256 * i, row = q_ >> 3, c8 = q_ & 7; *(LAS u32x4*)(lds + SSD_XN + 4096 * i + stX) = conv8(cidx * 64 + row, head * 64 + c8 * 8); }
        const float dec = do_vec();
        __syncthreads();
        if (k < 3) pdt = p.dtraw[(size_t)(NLAT + b * 256 + (dir ? 2 - k : k + 1) * 64 + lane) * 48 + dir * NHEADS + head];
        else prefetch(dir ? 63 : 0);
        load_xf();
        do_state(dec);
        __syncthreads();
        cur ^= 1;
    }
#pragma unroll 1
    for (int k = 4; k < 68; ++k) {
        const int cidx = dir ? 67 - k : k - 4;
        const int r0 = b * SEQ + cidx * 64;
#pragma unroll
        for (int i = 0; i < 4; ++i) { *(LAS u32x4*)(lds + SSD_BN + 4096 * i + stB) = pb[i]; *(LAS u32x4*)(lds + SSD_CN + 4096 * i + stB) = pc[i]; }
#pragma unroll
        for (int i = 0; i < 2; ++i) *(LAS u32x4*)(lds + SSD_XN + 4096 * i + stX) = px[i];
        const float dec = do_vec();
        if (k == 36) asm volatile("s_waitcnt vmcnt(0)" ::: "memory");
        __syncthreads();
        if (k + 1 < 68) prefetch(dir ? 66 - k : k - 3);
        const int t = 16 * w + L;
        const bool second = dir == 0 ? (cidx >= 32) : (cidx <= 31);
        bf16_t* yrow = p.av + (size_t)(r0 + t) * AVLD + 1024 + head * 64 + 4 * q;
        u32x2 yold[4], zz[4];
        if (second) {
            const bf16_t* zrow = p.z + (size_t)(r0 + t) * D_INNER + head * 64 + 4 * q;
#pragma unroll
            for (int pt = 0; pt < 4; ++pt) { yold[pt] = *(const u32x2*)(yrow + 16 * pt); zz[pt] = *(const u32x2*)(zrow + 16 * pt); }
        }
        load_xf();
        {
            const float acum_t = vec[t], ea = __expf(acum_t);
            bf16x8 Cf[4];
#pragma unroll
            for (int kn = 0; kn < 4; ++kn) Cf[kn] = *(const LAS bf16x8*)(lds + SSD_CN + w * 4096 + rk[kn]);
            f32x4 cbt[4];
#pragma unroll
            for (int j = 0; j < 4; ++j) {
                cbt[j] = (f32x4){0.f, 0.f, 0.f, 0.f};
                if (dir == 0 ? (j <= w) : (j >= w)) {
                    bf16x8 Bf[4];
#pragma unroll
                    for (int kn = 0; kn < 4; ++kn) Bf[kn] = *(const LAS bf16x8*)(lds + SSD_BN + j * 4096 + rk[kn]);
                    __builtin_amdgcn_sched_barrier(0);
#pragma unroll
                    for (int kn = 0; kn < 4; ++kn) cbt[j] = __builtin_amdgcn_mfma_f32_16x16x32_bf16(Bf[kn], Cf[kn], cbt[j], 0, 0, 0);
                }
            }
            bf16x8 Mf[2];
#pragma unroll
            for (int kk = 0; kk < 2; ++kk) {
                float m[8];
#pragma unroll
                for (int T = 0; T < 2; ++T) {
                    const int j = 2 * kk + T;
                    if (dir == 0 ? (j <= w) : (j >= w)) {
                        const f32x4 as_ = *(const LAS f32x4*)(vec + 32 * kk + 16 * T + 4 * q), ds_ = *(const LAS f32x4*)(vec + 64 + 32 * kk + 16 * T + 4 * q);
#pragma unroll
                        for (int r = 0; r < 4; ++r) {
                            const int s_ = 32 * kk + 16 * T + 4 * q + r; const bool valid = dir == 0 ? (s_ <= t) : (s_ >= t);
                            const float e = __expf(fminf(acum_t - as_[r], 0.f));
                            m[4 * T + r] = valid ? cbt[j][r] * e * ds_[r] : 0.f;
                        }
                    } else {
#pragma unroll
                        for (int r = 0; r < 4; ++r) m[4 * T + r] = 0.f;
                    }
                }
                Mf[kk] = ssd_pack8(m);
            }
            f32x4 yT[4];
            bf16x8 Hf[2][4];
#pragma unroll
            for (int kn = 0; kn < 4; ++kn) Hf[0][kn] = *(const LAS bf16x8*)(lds + SSD_HN + cur * 16384 + rk[kn]);
#pragma unroll
            for (int pt = 0; pt < 4; ++pt) {
                yT[pt] = (f32x4){0.f, 0.f, 0.f, 0.f};
                if (pt < 3) {
#pragma unroll
                    for (int kn = 0; kn < 4; ++kn) Hf[(pt + 1) & 1][kn] = *(const LAS bf16x8*)(lds + SSD_HN + cur * 16384 + (pt + 1) * 4096 + rk[kn]);
                }
                __builtin_amdgcn_sched_barrier(0);
#pragma unroll
                for (int kn = 0; kn < 4; ++kn) yT[pt] = __builtin_amdgcn_mfma_f32_16x16x32_bf16(Hf[pt & 1][kn], Cf[kn], yT[pt], 0, 0, 0);
                yT[pt] *= ea;
#pragma unroll
                for (int kk = 0; kk < 2; ++kk) yT[pt] = __builtin_amdgcn_mfma_f32_16x16x32_bf16(Xf[pt][kk], Mf[kk], yT[pt], 0, 0, 0);
            }
            do_state(dec);
            float ssq_acc = 0.f;
#pragma unroll
            for (int pt = 0; pt < 4; ++pt) {
                float o[4] = {yT[pt][0], yT[pt][1], yT[pt][2], yT[pt][3]};
                if (dir == 0) { const u32x2 xx = *(const LAS u32x2*)(lds + SSD_XN + ssd_offx(t, pt) + 8 * q);
                    o[0] += dsk * __uint_as_float(xx[0] << 16); o[1] += dsk * __uint_as_float(xx[0] & 0xffff0000u); o[2] += dsk * __uint_as_float(xx[1] << 16); o[3] += dsk * __uint_as_float(xx[1] & 0xffff0000u); }
                if (second) { const u32x2 yo = yold[pt], zv = zz[pt];
                    o[0] += __uint_as_float(yo[0] << 16); o[1] += __uint_as_float(yo[0] & 0xffff0000u); o[2] += __uint_as_float(yo[1] << 16); o[3] += __uint_as_float(yo[1] & 0xffff0000u);
                    o[0] *= siluf(__uint_as_float(zv[0] << 16)); o[1] *= siluf(__uint_as_float(zv[0] & 0xffff0000u)); o[2] *= siluf(__uint_as_float(zv[1] << 16)); o[3] *= siluf(__uint_as_float(zv[1] & 0xffff0000u));
                    ssq_acc += (o[0] * o[0] + o[1] * o[1]) + (o[2] * o[2] + o[3] * o[3]); }
                *(u32x2*)(yrow + 16 * pt) = (u32x2){g8::cvt_pk_bf16(o[0], o[1]), g8::cvt_pk_bf16(o[2], o[3])};
            }
            if (second) { ssq_acc += __shfl_xor(ssq_acc, 16); ssq_acc += __shfl_xor(ssq_acc, 32); if (q == 0) p.ssq[(size_t)(r0 + t) * NHEADS + head] = ssq_acc; }
        }
        __syncthreads();
        cur ^= 1;
    }
}

__device__ __forceinline__ void phase_post1(const Params& p, int bid, int nblk, char* smem) {
    const int TIDX = otid();
    float* srow = (float*)smem;
    float* part = srow + 32 * 1024;
    const int lane = TIDX & 63, wv = TIDX >> 6, e = lane & 15, ks = lane >> 4;
    float wreg[32];
    { const float* wr_ = p.w_router + (size_t)(128 * wv + 32 * ks) * 16 + e;
#pragma unroll
      for (int i = 0; i < 32; ++i) wreg[i] = wr_[i * 16]; }
    uint2 mu[2][4]; float4 xall[4][4];
    auto loadrows = [&](int r0) {
#pragma unroll
        for (int rr = 0; rr < 4; ++rr)
#pragma unroll
            for (int i = 0; i < 4; ++i) { const size_t o = (size_t)(r0 + wv * 4 + rr) * 1024 + i * 256 + lane * 4; const f32x4 t_ = __builtin_nontemporal_load((const f32x4*)(p.x + o)); xall[rr][i] = make_float4(t_[0], t_[1], t_[2], t_[3]); }
    };
    if (bid * 32 < NLAT) loadrows(bid * 32);
    for (int r0 = bid * 32; r0 < NLAT; r0 += nblk * 32) {
#pragma unroll
        for (int rr = 0; rr < 2; ++rr)
#pragma unroll
            for (int i = 0; i < 4; ++i) mu[rr][i] = *(const uint2*)(p.mix + (size_t)(r0 + wv * 4 + rr) * 1024 + i * 256 + lane * 4);
#pragma unroll
        for (int rr = 0; rr < 4; ++rr) {
            const int rl = wv * 4 + rr, row = r0 + rl;
            const int b = row / SEQ; const float* mv = p.mod + b * 6144;
            if (rr == 2) {
#pragma unroll
                for (int r2 = 0; r2 < 2; ++r2)
#pragma unroll
                    for (int i = 0; i < 4; ++i) mu[r2][i] = *(const uint2*)(p.mix + (size_t)(r0 + wv * 4 + 2 + r2) * 1024 + i * 256 + lane * 4);
            }
            float mx[16]; float ss = 0.f;
#pragma unroll
            for (int i = 0; i < 4; ++i) {
                const uint2 u = mu[rr & 1][i];
                mx[i * 4 + 0] = __uint_as_float(u.x << 16); mx[i * 4 + 1] = __uint_as_float(u.x & 0xffff0000u);
                mx[i * 4 + 2] = __uint_as_float(u.y << 16); mx[i * 4 + 3] = __uint_as_float(u.y & 0xffff0000u);
            }
            float4 xv[4];
#pragma unroll
            for (int i = 0; i < 4; ++i) xv[i] = xall[rr][i];
#pragma unroll
            for (int i = 0; i < 16; ++i) ss += mx[i] * mx[i];
            ss = wave_sum(ss);
            const float rstd = rsqrtf(ss * (1.0f / 1024.0f) + RMS_EPS);
            float hx[16]; float ss2 = 0.f;
#pragma unroll
            for (int i = 0; i < 4; ++i) {
                const int k = i * 256 + lane * 4;
                const f32x4 g1 = *(const f32x4*)(mv + 2048 + k), nw = *(const f32x4*)(p.norm_mix_post + k);
                const float xs[4] = {xv[i].x, xv[i].y, xv[i].z, xv[i].w};
#pragma unroll
                for (int j = 0; j < 4; ++j) { const float v = xs[j] + g1[j] * (mx[i * 4 + j] * rstd * nw[j]); hx[i * 4 + j] = v; ss2 += v * v; }
                *(uint2*)(p.hx1 + (size_t)row * 1024 + k) = make_uint2(g8::cvt_pk_bf16(hx[i * 4], hx[i * 4 + 1]), g8::cvt_pk_bf16(hx[i * 4 + 2], hx[i * 4 + 3]));
            }
            ss2 = wave_sum(ss2);
            const float rstd2 = rsqrtf(ss2 * (1.0f / 1024.0f) + RMS_EPS);
#pragma unroll
            for (int i = 0; i < 4; ++i) {
                const int k = i * 256 + lane * 4;
                const f32x4 nw = *(const f32x4*)(p.norm_ffn_pre + k), sc2 = *(const f32x4*)(mv + 4096 + k), sh2 = *(const f32x4*)(mv + 3072 + k);
                f32x4 vv;
#pragma unroll
                for (int j = 0; j < 4; ++j) vv[j] = hx[i * 4 + j] * rstd2 * nw[j] * (1.0f + sc2[j]) + sh2[j];
                *(f32x4*)(srow + rl * 1024 + k) = vv;
                { int pk = __builtin_amdgcn_cvt_pk_fp8_f32(clamp8(vv[0]), clamp8(vv[1]), 0, false); pk = __builtin_amdgcn_cvt_pk_fp8_f32(clamp8(vv[2]), clamp8(vv[3]), pk, true); *(int*)(p.h2q + (size_t)row * 1024 + k) = pk; }
            }
            asm volatile("" ::: "memory");
        }
        __syncthreads();
        if (r0 + nblk * 32 < NLAT) loadrows(r0 + nblk * 32);
#pragma unroll 2
        for (int r = 0; r < 32; ++r) {
            const float* sr = srow + r * 1024 + 128 * wv + 32 * ks;
            float acc = 0.f;
#pragma unroll
            for (int i4 = 0; i4 < 8; ++i4) { const f32x4 hv = *(const f32x4*)(sr + 4 * i4); acc += hv[0] * wreg[4 * i4] + hv[1] * wreg[4 * i4 + 1] + hv[2] * wreg[4 * i4 + 2] + hv[3] * wreg[4 * i4 + 3]; }
            acc += __shfl_xor(acc, 16); acc += __shfl_xor(acc, 32);
            if (lane < 16) part[(r * 8 + wv) * 16 + e] = acc;
        }
        __syncthreads();
        {
            const int r = TIDX >> 4;
            float lg = 0.f;
#pragma unroll
            for (int w8 = 0; w8 < 8; ++w8) lg += part[(r * 8 + w8) * 16 + e];
            float mxl = lg;
#pragma unroll
            for (int o = 8; o >= 1; o >>= 1) mxl = fmaxf(mxl, __shfl_xor(mxl, o));
            const float ex = __expf(lg - mxl);
            float se = ex;
#pragma unroll
            for (int o = 8; o >= 1; o >>= 1) se += __shfl_xor(se, o);
            p.aff[(size_t)(r0 + r) * 16 + e] = ex * frcp(se);
        }
        __syncthreads();
    }
}

__device__ __forceinline__ void phase_topk(const Params& p, int bid, int nblk, char* smem) {
    const int TIDX = otid();
    unsigned* keys = (unsigned*)smem;
    unsigned* hist = keys + 4096;
    unsigned* scanbuf = hist + 256;
    unsigned* sh = scanbuf + 512;
    const int tid = TIDX;
    for (int be = bid; be < BATCH * N_EXP; be += nblk) {
        const int b = be >> 4, e = be & 15;
        __syncthreads();
        for (int i = tid; i < 4096; i += NT) keys[i] = __float_as_uint(p.aff[(size_t)(b * SEQ + i) * 16 + e]);
        unsigned prefix = 0, mask = 0, need = CAP;
        for (int pass = 0; pass < 4; ++pass) {
            const int shift = 24 - 8 * pass;
            if (tid < 256) hist[tid] = 0;
            __syncthreads();
            for (int i = tid; i < 4096; i += NT) { const unsigned k = keys[i]; if ((k & mask) == prefix) atomicAdd(&hist[(k >> shift) & 255u], 1u); }
            __syncthreads();
            if (tid < 64) {
                const unsigned c0 = hist[4 * tid], c1 = hist[4 * tid + 1], c2 = hist[4 * tid + 2], c3 = hist[4 * tid + 3];
                unsigned S = c0 + c1 + c2 + c3;
#pragma unroll
                for (int o = 1; o < 64; o <<= 1) { const unsigned t = __shfl_down(S, o); if (tid + o < 64) S += t; }
                const unsigned long long m = __ballot(S >= need);
                const int Lsel = 63 - __builtin_clzll(m);
                unsigned above = __shfl_down(S, 1); if (tid == 63) above = 0;
                if (tid == Lsel) {
                    unsigned cum = above; int sel;
                    if (cum + c3 >= need) sel = 3; else { cum += c3; if (cum + c2 >= need) sel = 2; else { cum += c2; if (cum + c1 >= need) sel = 1; else { cum += c1; sel = 0; } } }
                    sh[0] = prefix | ((unsigned)(4 * tid + sel) << shift); sh[1] = need - cum;
                }
            }
            __syncthreads();
            prefix = sh[0]; need = sh[1]; mask |= 255u << shift;
            __syncthreads();
        }
        const unsigned T = prefix;
        unsigned cgt = 0, ceq = 0;
        for (int i = 0; i < 8; ++i) { const unsigned k = keys[tid * 8 + i]; cgt += (k > T); ceq += (k == T); }
        unsigned incl = cgt | (ceq << 16);
        { const int ln = tid & 63;
#pragma unroll
          for (int o = 1; o < 64; o <<= 1) { const unsigned t = __shfl_up(incl, o); if (ln >= o) incl += t; }
          if (ln == 63) scanbuf[tid >> 6] = incl; }
        __syncthreads();
        unsigned woff = 0;
        for (int w = 0; w < (tid >> 6); ++w) woff += scanbuf[w];
        const unsigned excl = woff + incl - (cgt | (ceq << 16));
        unsigned posg = excl & 0xffffu, pose = excl >> 16;
        const unsigned ngreater = CAP - need;
        for (int i = 0; i < 8; ++i) {
            const int tok = tid * 8 + i; const unsigned k = keys[tok];
            int slot = -1;
            if (k > T) slot = (int)(posg++);
            else if (k == T) { if (pose < need) slot = (int)(ngreater + pose); pose++; }
            p.slot_of[(size_t)(b * SEQ + tok) * 16 + e] = slot;
            if (slot >= 0) { p.topidx[be * CAP + slot] = tok; p.topaff[be * CAP + slot] = __uint_as_float(k); }
        }
    }
}

__device__ __forceinline__ void phase_final(const Params& p, int bid, int nblk) {
    const int TIDX = otid();
    const int lane = TIDX & 63;
    for (int row2 = (bid * 8 + (TIDX >> 6)) * 2; row2 < NLAT; row2 += nblk * 16) {
        const int b = row2 / SEQ; const float* mv = p.mod + b * 6144;
        const int myslot = lane < 32 ? p.slot_of[(size_t)row2 * 16 + lane] : -1;
        float4 hv[2][4];
#pragma unroll
        for (int r = 0; r < 2; ++r)
#pragma unroll
            for (int i = 0; i < 4; ++i) { const uint2 u = *(const uint2*)(p.hx1 + (size_t)(row2 + r) * 1024 + i * 256 + lane * 4);
                hv[r][i] = make_float4(__uint_as_float(u.x << 16), __uint_as_float(u.x & 0xffff0000u), __uint_as_float(u.y << 16), __uint_as_float(u.y & 0xffff0000u)); }
        const unsigned long long mall = __ballot(myslot >= 0);
#pragma unroll
        for (int r = 0; r < 2; ++r) {
            unsigned long long m = (mall >> (16 * r)) & 0xffffull;
            float acc[16];
#pragma unroll
            for (int i = 0; i < 16; ++i) acc[i] = 0.f;
            while (m) {
                const int e0 = __builtin_ctzll(m); m &= m - 1;
                const bool two = m != 0; const int e1 = two ? __builtin_ctzll(m) : e0; if (two) m &= m - 1;
                const int s0 = __shfl(myslot, 16 * r + e0), s1 = __shfl(myslot, 16 * r + e1);
                const bf16_t* src0 = p.ye + ((size_t)(b * 16 + e0) * CAP + s0) * 1024 + lane * 4;
                const bf16_t* src1 = p.ye + ((size_t)(b * 16 + e1) * CAP + s1) * 1024 + lane * 4;
                uint2 u0[4], u1[4];
#pragma unroll
                for (int i = 0; i < 4; ++i) { u0[i] = *(const uint2*)(src0 + i * 256); u1[i] = *(const uint2*)(src1 + i * 256); }
                const float f1 = two ? 1.f : 0.f;
#pragma unroll
                for (int i = 0; i < 4; ++i) {
                    acc[i * 4 + 0] += __uint_as_float(u0[i].x << 16) + f1 * __uint_as_float(u1[i].x << 16); acc[i * 4 + 1] += __uint_as_float(u0[i].x & 0xffff0000u) + f1 * __uint_as_float(u1[i].x & 0xffff0000u);
                    acc[i * 4 + 2] += __uint_as_float(u0[i].y << 16) + f1 * __uint_as_float(u1[i].y << 16); acc[i * 4 + 3] += __uint_as_float(u0[i].y & 0xffff0000u) + f1 * __uint_as_float(u1[i].y & 0xffff0000u);
                }
            }
            float ss = 0.f;
#pragma unroll
            for (int i = 0; i < 16; ++i) ss += acc[i] * acc[i];
            ss = wave_sum(ss);
            const float rstd = rsqrtf(ss * (1.0f / 1024.0f) + RMS_EPS);
#pragma unroll
            for (int i = 0; i < 4; ++i) {
                const int k = i * 256 + lane * 4;
                const f32x4 g2 = *(const f32x4*)(mv + 5120 + k), nw = *(const f32x4*)(p.norm_ffn_post + k);
                float4 o = hv[r][i];
                o.x += g2[0] * (acc[i * 4 + 0] * rstd * nw[0]); o.y += g2[1] * (acc[i * 4 + 1] * rstd * nw[1]);
                o.z += g2[2] * (acc[i * 4 + 2] * rstd * nw[2]); o.w += g2[3] * (acc[i * 4 + 3] * rstd * nw[3]);
                *(float4*)(p.out + (size_t)(row2 + r) * 1024 + k) = o;
            }
        }
    }
}

struct KArgs { const float* in[25]; float* out; char* ws; unsigned* bar; };
__device__ __host__ __forceinline__ Params expand(const KArgs& k) {
    Params p{};
    p.x = k.in[0]; p.c = k.in[1]; p.ctx = k.in[2]; p.c_ctx = k.in[3]; p.w_mod = k.in[4]; p.b_mod = k.in[5]; p.norm_mix_pre = k.in[6]; p.norm_mix_post = k.in[7];
    p.norm_ffn_pre = k.in[8]; p.norm_ffn_post = k.in[9]; p.w_in = k.in[10]; p.conv_w = k.in[11]; p.conv_b = k.in[12]; p.dt_bias = k.in[13]; p.a_log = k.in[14]; p.d_skip = k.in[15];
    p.ssd_norm = k.in[16]; p.w_fourier = k.in[17]; p.w_ssd_out = k.in[18]; p.b_gate = k.in[19]; p.w_out = k.in[20]; p.w_router = k.in[21]; p.w_e_gate = k.in[22]; p.w_e_up = k.in[23]; p.w_e_down = k.in[24];
    p.out = k.out;
    char* ws = k.ws; const size_t MiB = 1u << 20;
    p.xbc = (bf16_t*)(ws + 0 * MiB);
    p.mix = (bf16_t*)(ws + 0 * MiB);
    p.hid = (bf16_t*)(ws + 0 * MiB);
    p.z = (bf16_t*)(ws + 170 * MiB);
    p.h2 = (bf16_t*)(ws + 170 * MiB);
    p.WdT = (bf16_t*)(ws + 234 * MiB);
    p.av = (bf16_t*)(ws + 266 * MiB);
    p.h = (bf16_t*)(ws + 266 * MiB);
    p.uf = (bf16_t*)(ws + 334 * MiB);
    p.WinT = (bf16_t*)(ws + 366 * MiB);
    p.WguT = (bf16_t*)(ws + 266 * MiB);
    p.ye = (bf16_t*)(ws + 266 * MiB);
    p.ufT = (bf16_t*)(ws + 426 * MiB);
    p.dmat = (bf16_t*)(ws + 458 * MiB);
    p.ueT = (bf16_t*)((char*)k.out + 64 * MiB);
    p.uoT = (bf16_t*)((char*)k.out + 80 * MiB);
    p.umid = (float*)(ws + 510 * MiB + 262144);
    p.ualt = (float*)(ws + 510 * MiB + 278528);
    p.merged = (bf16_t*)(ws + 64 * MiB);
    p.WmT = (bf16_t*)(ws + 490 * MiB);
    p.WoT = (bf16_t*)(ws + 495 * MiB);
    p.dtraw = (float*)(ws + 497 * MiB);
    p.mod = (float*)(ws + 504 * MiB);
    p.aff = (float*)(ws + 505 * MiB);
    p.slot_of = (int*)(ws + 507 * MiB);
    p.ssq = (float*)(ws + 505 * MiB);
    p.h2q = (unsigned char*)(ws + 170 * MiB);
    p.hx1 = (bf16_t*)(ws + 394 * MiB);
    p.hq = (signed char*)(ws + 266 * MiB);
    p.WinQ = (signed char*)(ws + 366 * MiB);
    p.colmax = (unsigned*)(ws + 510 * MiB + 16384);
    p.wscale = (float*)(ws + 510 * MiB + 49152);
    p.hscale = (float*)(ws + 510 * MiB + 98304);
    p.WdT8 = (unsigned char*)(ws + 474 * MiB);
    p.WguT8 = (unsigned char*)((char*)k.out + 96 * MiB);
    p.hid8 = (unsigned char*)(ws + 0 * MiB);
    p.topidx = (int*)(ws + 509 * MiB);
    p.topaff = (float*)(ws + 509 * MiB + 512 * 1024);
    p.gq = (unsigned char*)k.out;
    return p;
}
__global__ void __launch_bounds__(NT) mega(KArgs ka) {
    const Params p = expand(ka);
    extern __shared__ __attribute__((aligned(16))) char smem[];
    cg::grid_group grid = cg::this_grid();
    const int bid = blockIdx.x, nblk = gridDim.x;
    LAS unsigned char* lds = (LAS unsigned char*)smem;
    volatile LAS unsigned* xst = (volatile LAS unsigned*)(lds + XB_LDS_OFF);
    if (threadIdx.x < 4) xst[threadIdx.x] = 0u;
    __syncthreads();
    const XcdBarrier xbar = xcd_barrier_post(ka.bar, xst);
    if (ka.ws == nullptr) grid.sync();
    phase_colmax(p, bid, nblk);
    phase_mod(p, bid, nblk, smem);
    phase_prep(p, bid, nblk, smem);
    xcd_barrier(xbar);
    tr_stream_q(p, bid, nblk, smem);
    phase_modulate(p, bid, nblk);
    xcd_barrier(xbar);
    { const int tq = otid();
      for (int i = tq; i < CONV_CH; i += NT) *(LAS u32x2*)(lds + CONVT_OFF + i * 8) = (u32x2){g8::cvt_pk_bf16(p.conv_w[i], p.conv_w[CONV_CH + i]), g8::cvt_pk_bf16(p.conv_w[2 * CONV_CH + i], p.conv_b[i])};
      __syncthreads(); }
    { SchedInProj S{(const char*)p.hq, (const char*)p.WinQ, nblk, bid}; EpiInProj E{p, lds}; g8::gemm8<EpiInProj, SchedInProj, false, false, true>(lds, 1024u, 1024u, S, E); }
    xcd_barrier(xbar);
    if (bid >= 192) { dft_evenodd(p, bid - 192); SchedDft S{(const char*)p.dmat, (const char*)p.ueT, (const char*)p.uoT, bid - 192}; EpiDft E{p}; g8::gemm8<EpiDft, SchedDft, false>(lds, 4096u, 4096u, S, E);
                      phase_prep2(p, bid - 192, nblk - 192, 0, PREP2_SPLIT, smem); }
    phase_ssd(p, bid, nblk, smem);
    xcd_barrier(xbar);
    merged_prologue(p, bid, nblk, lds);
    { SchedMerged S{(const char*)p.av, (const char*)p.WmT, nblk, bid}; EpiMerged E{p, lds}; g8::gemm8<EpiMerged, SchedMerged, false>(lds, AVLD * 2u, AVLD * 2u, S, E); }
    xcd_barrier(xbar);
    { SchedWOut S{(const char*)p.merged, (const char*)p.WoT, nblk, bid}; EpiWOut E{p}; g8::gemm8<EpiWOut, SchedWOut, false>(lds, 2048u, 2048u, S, E); }
    xcd_barrier(xbar);
    phase_post1(p, bid, nblk, smem);
    xcd_barrier(xbar);
    phase_topk(p, bid, nblk, smem);
    phase_prep2(p, bid, nblk, PREP2_SPLIT, 6144, smem);
    xcd_barrier(xbar);
    { SchedExpUp S{(const char*)p.h2q, (const char*)p.WguT8, p.topidx, nblk, bid}; EpiExpUp E{p}; g8::gemm8<EpiExpUp, SchedExpUp, true, true>(lds, 1024u, 1024u, S, E); }
    xcd_barrier(xbar);
    { SchedExpDown S{(const char*)p.hid8, (const char*)p.WdT8, nblk, bid}; EpiExpDown E{p}; g8::gemm8<EpiExpDown, SchedExpDown, false, true>(lds, 1024u, 1024u, S, E); }
    xcd_barrier(xbar);
    phase_final(p, bid, nblk);
}

extern "C" void kernel_launch(void* const* d_in, const int* in_sizes, int n_in, void* d_out, int out_size, void* d_ws, size_t ws_size, hipStream_t stream) {
    static int grid_blocks = 0;
    if (!grid_blocks) {
        int dev = 0, cus = 0, per_cu = 0;
        (void)hipGetDevice(&dev);
        (void)hipDeviceGetAttribute(&cus, hipDeviceAttributeMultiprocessorCount, dev);
        (void)hipFuncSetAttribute((const void*)mega, hipFuncAttributeMaxDynamicSharedMemorySize, SMEM_BYTES);
        (void)hipOccupancyMaxActiveBlocksPerMultiprocessor(&per_cu, mega, NT, SMEM_BYTES);
        if (per_cu > 1) per_cu = 1;
        grid_blocks = cus * per_cu;
    }
    KArgs ka{};
    for (int i = 0; i < 25; ++i) ka.in[i] = (const float*)d_in[i];
    ka.out = (float*)d_out; ka.ws = (char*)d_ws; ka.bar = (unsigned*)((char*)d_ws + (size_t)510 * (1u << 20));
    (void)hipMemsetAsync(ka.bar, 0, 49152, stream);
    void* args[] = {&ka};
    hipError_t e = hipLaunchCooperativeKernel((const void*)mega, dim3(grid_blocks), dim3(NT), args, SMEM_BYTES, stream);
    if (e != hipSuccess) fprintf(stderr, "cooperative launch failed: %s (grid %d)\n", hipGetErrorString(e), grid_blocks);
}
```

```cpp
#include <hip/hip_runtime.h>
#include <hip/hip_cooperative_groups.h>
#include <stdint.h>
#include <cstdio>
namespace cg = cooperative_groups;
#define NT 512

typedef unsigned short bf16_t;
typedef short bf16x8 __attribute__((ext_vector_type(8)));
typedef float f32x4 __attribute__((ext_vector_type(4)));

#define D_MODEL 1024
#define BATCH 8
#define SEQ 4096
#define CTX 256
#define NLAT (BATCH * SEQ)
#define NCTX (BATCH * CTX)
#define NTOK (NLAT + NCTX)
#define F_WIDTH 512
#define D_INNER 1536
#define CONV_CH 2560
#define NHEADS 24
#define P_IN 6704
#define N_EXP 16
#define CAP 512
#define RMS_EPS 1e-6f
#define SMEM_BYTES (153600 + 64)
#define XB_LDS_OFF 153600
#define MERGED_RS_OFF 131072
#define CONVT_OFF 133120
#define PREP2_SPLIT 3840

__device__ __forceinline__ bf16_t f2bf(float f) { unsigned u = __float_as_uint(f); u += 0x7FFFu + ((u >> 16) & 1u); return (bf16_t)(u >> 16); }
__device__ __forceinline__ float bf2f(bf16_t b) { return __uint_as_float(((unsigned)b) << 16); }
__device__ __forceinline__ float frcp(float v) { return __builtin_amdgcn_rcpf(v); }
__device__ __forceinline__ float siluf(float v) { return v * frcp(1.0f + __expf(-v)); }
__device__ __forceinline__ float clamp8(float v) { return __builtin_amdgcn_fmed3f(v, -448.0f, 448.0f); }
__device__ __forceinline__ float sigmoidf(float v) { return frcp(1.0f + __expf(-v)); }
__device__ __forceinline__ int otid() { int t = threadIdx.x; asm volatile("" : "+v"(t)); return t; }
#define WAVE_DPP(v, ctrl) __int_as_float(__builtin_amdgcn_update_dpp(0, __float_as_int(v), ctrl, 0xF, 0xF, false))
__device__ __forceinline__ float wave_sum(float v) {
    v += WAVE_DPP(v, 0xB1); v += WAVE_DPP(v, 0x4E); v += WAVE_DPP(v, 0x141); v += WAVE_DPP(v, 0x140);
    const int vi = __float_as_int(v);
    return (__int_as_float(__builtin_amdgcn_readlane(vi, 0)) + __int_as_float(__builtin_amdgcn_readlane(vi, 16))) + (__int_as_float(__builtin_amdgcn_readlane(vi, 32)) + __int_as_float(__builtin_amdgcn_readlane(vi, 48)));
}
__device__ __forceinline__ float wave_max(float v) {
    v = fmaxf(v, WAVE_DPP(v, 0xB1)); v = fmaxf(v, WAVE_DPP(v, 0x4E)); v = fmaxf(v, WAVE_DPP(v, 0x141)); v = fmaxf(v, WAVE_DPP(v, 0x140));
    const int vi = __float_as_int(v);
    return fmaxf(fmaxf(__int_as_float(__builtin_amdgcn_readlane(vi, 0)), __int_as_float(__builtin_amdgcn_readlane(vi, 16))), fmaxf(__int_as_float(__builtin_amdgcn_readlane(vi, 32)), __int_as_float(__builtin_amdgcn_readlane(vi, 48))));
}

struct Params {
    const float *x, *c, *ctx, *c_ctx, *w_mod, *b_mod, *norm_mix_pre, *norm_mix_post, *norm_ffn_pre, *norm_ffn_post;
    const float *w_in, *conv_w, *conv_b, *dt_bias, *a_log, *d_skip, *ssd_norm, *w_fourier, *w_ssd_out, *b_gate, *w_out;
    const float *w_router, *w_e_gate, *w_e_up, *w_e_down;
    float* out;
    float* mod;
    float* pmod;
    bf16_t* h;
    bf16_t* uf;
    bf16_t* z;
    bf16_t* xbc;
    float* dtraw;
    unsigned char* gq;
    bf16_t* pq;
    bf16_t* f;
    bf16_t* y;
    bf16_t* merged;
    unsigned char* merged8;
    bf16_t* mix;
    bf16_t* h2;
    float* aff;
    int* topidx;
    float* topaff;
    int* slot_of;
    bf16_t* hid;
    bf16_t* ye;
    unsigned char* ye8;
    bf16_t* av;
    bf16_t* ufT;
    signed char* dmat;
    signed char* ueT;
    signed char* uoT;
    float* use;
    float* uso;
    float* umid;
    float* ualt;
    bf16_t* WinT;
    bf16_t* WmT;
    bf16_t* WoT;
    unsigned char* WoT8;
    bf16_t* WguT;
    bf16_t* WdT;
    float* ssq;
    bf16_t* hx1;
    unsigned char* h2q;
    signed char* hq;
    float* hscale;
    signed char* WinQ;
    float* wscale;
    unsigned* colmax;
    unsigned char* hid8;
    unsigned char* WguT8;
    unsigned char* WdT8;
};
#define AVLD 2560


#define LAS __attribute__((address_space(3)))
typedef unsigned u32x4 __attribute__((ext_vector_type(4)));
typedef unsigned u32x2 __attribute__((ext_vector_type(2)));
namespace g8 {
constexpr int BM = 256, BK = 64, HALF = 128, HTB = HALF * BK * 2, STAGE_BYTES = 8 * HTB;
__device__ __forceinline__ int lds_byte(int r, int c) { const int st = (r >> 4) * 2 + (c >> 5), rr = r & 15, cc = c & 31, ob = rr * 64 + cc * 2; return st * 1024 + (ob ^ (((ob >> 9) & 1) << 5)); }
__device__ __forceinline__ void stage_rc(int b, int& R, int& C) { const int st = b / 1024, sb = b % 1024, swz = sb ^ (((sb >> 9) & 1) << 5); R = (st >> 1) * 16 + swz / 64; C = (st & 1) * 32 + (swz % 64) / 2; }
__device__ __forceinline__ int perm32(int rho) { const int n = rho >> 4, i = rho & 15; return 8 * (i >> 2) + 4 * n + (i & 3); }
typedef float f32x2_ __attribute__((ext_vector_type(2)));
typedef __bf16 bf16x2_ __attribute__((ext_vector_type(2)));
__device__ __forceinline__ unsigned cvt_pk_bf16(float lo, float hi) { union { bf16x2_ b; unsigned u; } cv; cv.b = __builtin_convertvector((f32x2_){lo, hi}, bf16x2_); return cv.u; }
struct Unit { const char* A; const char* B; const int* gidx; int nt, pm, pn, aux; };
__device__ __forceinline__ void grid_map(int L, int nM, int nN, int& pm, int& pn) {
    const int nwg = nM * nN; int wgid = L;
    { const int q = nwg / 8, r = nwg % 8, xcd = wgid % 8, off = wgid / 8; wgid = (xcd < r ? xcd * (q + 1) : r * (q + 1) + (xcd - r) * q) + off; }
    const int nig = 8 * nN, gid = wgid / nig, fm = gid * 8, gsz = (nM - fm) < 8 ? (nM - fm) : 8;
    pm = fm + ((wgid % nig) % gsz); pn = (wgid % nig) / gsz;
}
typedef int i32x8 __attribute__((ext_vector_type(8)));
typedef int i32x4v __attribute__((ext_vector_type(4)));
__device__ __forceinline__ i32x8 cat16(const bf16x8 lo, const bf16x8 hi) { union { bf16x8 b; i32x4v i; } a, c; a.b = lo; c.b = hi; return __builtin_shufflevector(a.i, c.i, 0, 1, 2, 3, 4, 5, 6, 7); }
template <class Epi, class Sched, bool GATHER, bool FP8 = false, bool I8 = false, bool MIXED = false>
__device__ __forceinline__ void gemm8(LAS unsigned char* lds, const unsigned lda, const unsigned ldb, const Sched& S, const Epi& E) {
    int tid_ = threadIdx.x; asm volatile("" : "+v"(tid_));
    const int tid = tid_, wid = __builtin_amdgcn_readfirstlane(tid >> 6), lane = tid & 63, wr = wid >> 2, wc = wid & 3, fr = lane & 15, fq = lane >> 4;
    unsigned voffB[2], va[2][2], vn[2][2]; int RA[2], CA[2];
#pragma unroll
    for (int i = 0; i < 2; ++i) { int R, C; stage_rc(tid * 16 + i * 8192, R, C); const int Rb = Epi::PERM ? ((R & ~31) + perm32(R & 31)) : R;
        RA[i] = R; CA[i] = C; voffB[i] = (unsigned)Rb * ldb + (unsigned)C * 2u; va[0][i] = (unsigned)R * lda + (unsigned)C * 2u; va[1][i] = (unsigned)(R + HALF) * lda + (unsigned)C * 2u; vn[0][i] = va[0][i]; vn[1][i] = va[1][i]; }
    const size_t kstep = (size_t)(BK * 2);
    const size_t hstepB = (size_t)HALF * ldb;
    const unsigned ldsw = (unsigned)wid * 1024u;
    const int aoff = lds_byte(wr * 64 + fr, fq * 8), boff = lds_byte(wc * 32 + fr, fq * 8);
#define G8_SA(b, h) (((b) * 2 + (h)) * HTB)
#define G8_SB(b, h) ((4 + (b) * 2 + (h)) * HTB)
#define G8_STAGE(bufoff, gbase, v0, v1) do { \
        __builtin_amdgcn_global_load_lds((const unsigned*)((const char*)(gbase) + (v0)), (LAS unsigned*)(lds + (bufoff) + ldsw), 16, 0, 0); \
        __builtin_amdgcn_global_load_lds((const unsigned*)((const char*)(gbase) + (v1)), (LAS unsigned*)(lds + (bufoff) + ldsw + 8192), 16, 0, 0); } while (0)
#define G8_LDA(dst, b, h) do { if constexpr (FP8 || MIXED) { _Pragma("unroll") for (int m = 0; m < 4; ++m) { const i32x4v lo_ = *(const LAS i32x4v*)(lds + G8_SA(b, h) + aoff + m * 2048), hi_ = *(const LAS i32x4v*)(lds + G8_SA(b, h) + aoff + m * 2048 + 1024); dst##8[m] = __builtin_shufflevector(lo_, hi_, 0, 1, 2, 3, 4, 5, 6, 7); } } \
        else { _Pragma("unroll") for (int m = 0; m < 4; ++m) _Pragma("unroll") for (int k = 0; k < 2; ++k) dst[m][k] = *(const LAS bf16x8*)(lds + G8_SA(b, h) + aoff + m * 2048 + k * 1024); } } while (0)
#define G8_LDB(dst, b, h) do { if constexpr (FP8 || MIXED) { _Pragma("unroll") for (int n = 0; n < 2; ++n) { const i32x4v lo_ = *(const LAS i32x4v*)(lds + G8_SB(b, h) + boff + n * 2048), hi_ = *(const LAS i32x4v*)(lds + G8_SB(b, h) + boff + n * 2048 + 1024); dst##8[n] = __builtin_shufflevector(lo_, hi_, 0, 1, 2, 3, 4, 5, 6, 7); } } \
        else { _Pragma("unroll") for (int n = 0; n < 2; ++n) _Pragma("unroll") for (int k = 0; k < 2; ++k) dst[n][k] = *(const LAS bf16x8*)(lds + G8_SB(b, h) + boff + n * 2048 + k * 1024); } } while (0)
#define G8_MMA(ai, bj, At, Bt) do { __builtin_amdgcn_s_setprio(1); \
        if constexpr (MIXED) { if constexpr (f8u) { _Pragma("unroll") for (int m = 0; m < 4; ++m) _Pragma("unroll") for (int n = 0; n < 2; ++n) \
            asm volatile("v_mfma_scale_f32_16x16x128_f8f6f4 %0, %1, %2, %0, %3, %4 op_sel_hi:[0,0,0]" : "+v"(acc[ai][bj][m][n]) : "v"(Bt##8[n]), "v"(At##8[m]), "v"(sclb), "v"(scla)); } \
          else { _Pragma("unroll") for (int m = 0; m < 4; ++m) _Pragma("unroll") for (int n = 0; n < 2; ++n) \
            asm volatile("v_mfma_f32_16x16x32_bf16 %0, %1, %2, %0" : "+v"(acc[ai][bj][m][n]) : "v"(__builtin_shufflevector(Bt##8[n], Bt##8[n], 0, 1, 2, 3)), "v"(__builtin_shufflevector(At##8[m], At##8[m], 0, 1, 2, 3))); \
            _Pragma("unroll") for (int m = 0; m < 4; ++m) _Pragma("unroll") for (int n = 0; n < 2; ++n) \
            asm volatile("v_mfma_f32_16x16x32_bf16 %0, %1, %2, %0" : "+v"(acc[ai][bj][m][n]) : "v"(__builtin_shufflevector(Bt##8[n], Bt##8[n], 4, 5, 6, 7)), "v"(__builtin_shufflevector(At##8[m], At##8[m], 4, 5, 6, 7))); } } \
        else if constexpr (FP8) { _Pragma("unroll") for (int m = 0; m < 4; ++m) _Pragma("unroll") for (int n = 0; n < 2; ++n) \
            asm volatile("v_mfma_scale_f32_16x16x128_f8f6f4 %0, %1, %2, %0, %3, %4 op_sel_hi:[0,0,0]" : "+v"(acc[ai][bj][m][n]) : "v"(Bt##8[n]), "v"(At##8[m]), "v"(sclb), "v"(scla)); } \
        else if constexpr (I8) { _Pragma("unroll") for (int m = 0; m < 4; ++m) _Pragma("unroll") for (int n = 0; n < 2; ++n) _Pragma("unroll") for (int k = 0; k < 2; ++k) \
            acc[ai][bj][m][n] = __builtin_bit_cast(f32x4, __builtin_amdgcn_mfma_i32_16x16x64_i8(__builtin_bit_cast(i32x4v, Bt[n][k]), __builtin_bit_cast(i32x4v, At[m][k]), __builtin_bit_cast(i32x4v, acc[ai][bj][m][n]), 0, 0, 0)); } \
        else { _Pragma("unroll") for (int m = 0; m < 4; ++m) _Pragma("unroll") for (int n = 0; n < 2; ++n) _Pragma("unroll") for (int k = 0; k < 2; ++k) \
            acc[ai][bj][m][n] = __builtin_amdgcn_mfma_f32_16x16x32_bf16(Bt[n][k], At[m][k], acc[ai][bj][m][n], 0, 0, 0); } \
        __builtin_amdgcn_s_setprio(0); } while (0)
#define G8_WAIT_V(n) asm volatile("s_waitcnt vmcnt(" #n ")" ::: "memory")
#define G8_WAIT_L(n) asm volatile("s_waitcnt lgkmcnt(" #n ")" ::: "memory")
#define G8_BAR __builtin_amdgcn_s_barrier()
#define G8_SCHED __builtin_amdgcn_sched_barrier(0)
#define G8_KLOOP         for (int t = 0; t < nt; t += 2) { \
            const bool last = (t == nt - 2); \
            const char* a1 = cA + (size_t)(t + 1) * kstep; \
            const char* a2 = last ? nA : cA + (size_t)(t + 2) * kstep; const char* b2 = last ? nB : cB + (size_t)(t + 2) * kstep; \
            const char* a3 = a2 + kstep; const char* b3 = b2 + kstep; \
            const unsigned w00 = (GATHER && last) ? vn[0][0] : va[0][0], w01 = (GATHER && last) ? vn[0][1] : va[0][1]; \
            const unsigned w10 = (GATHER && last) ? vn[1][0] : va[1][0], w11 = (GATHER && last) ? vn[1][1] : va[1][1]; \
            G8_LDB(B0, 0, 0); G8_SCHED; G8_LDA(At, 0, 0); G8_STAGE(G8_SA(1, 1), a1, va[1][0], va[1][1]); \
            G8_WAIT_L(8); G8_BAR; G8_WAIT_L(0); G8_MMA(0, 0, At, B0); G8_BAR; G8_SCHED; \
            G8_LDB(B1, 0, 1); G8_STAGE(G8_SB(0, 0), b2, voffB[0], voffB[1]); \
            G8_BAR; G8_WAIT_L(0); G8_MMA(0, 1, At, B1); G8_BAR; \
            G8_LDA(At, 0, 1); G8_STAGE(G8_SA(0, 0), a2, w00, w01); \
            G8_BAR; G8_WAIT_L(0); G8_MMA(1, 0, At, B0); G8_BAR; G8_SCHED; \
            G8_STAGE(G8_SB(0, 1), b2 + hstepB, voffB[0], voffB[1]); \
            G8_WAIT_V(6); G8_BAR; G8_MMA(1, 1, At, B1); G8_BAR; \
            G8_LDB(B0, 1, 0); G8_SCHED; G8_LDA(At, 1, 0); G8_STAGE(G8_SA(0, 1), a2, w10, w11); \
            G8_WAIT_L(8); G8_BAR; G8_WAIT_L(0); G8_MMA(0, 0, At, B0); G8_BAR; G8_SCHED; \
            G8_LDB(B1, 1, 1); G8_STAGE(G8_SB(1, 0), b3, voffB[0], voffB[1]); \
            G8_BAR; G8_WAIT_L(0); G8_MMA(0, 1, At, B1); G8_BAR; \
            G8_LDA(At, 1, 1); G8_STAGE(G8_SA(1, 0), a3, w00, w01); \
            G8_BAR; G8_WAIT_L(0); G8_MMA(1, 0, At, B0); G8_BAR; G8_SCHED; \
            G8_STAGE(G8_SB(1, 1), b3 + hstepB, voffB[0], voffB[1]); \
            G8_WAIT_V(6); G8_BAR; G8_MMA(1, 1, At, B1); G8_BAR; \
        }
    Unit cur, nxt; int ui = 0;
    if (!S.next(0, cur)) return;
    if (GATHER) {
#pragma unroll
        for (int i = 0; i < 2; ++i) { va[0][i] = (unsigned)cur.gidx[RA[i]] * lda + (unsigned)CA[i] * 2u; va[1][i] = (unsigned)cur.gidx[RA[i] + HALF] * lda + (unsigned)CA[i] * 2u; }
    }
    f32x4 acc[2][2][4][2];
#pragma unroll
    for (int a = 0; a < 2; ++a)
#pragma unroll
        for (int b = 0; b < 2; ++b)
#pragma unroll
            for (int m = 0; m < 4; ++m)
#pragma unroll
                for (int n = 0; n < 2; ++n) acc[a][b][m][n] = (f32x4){0.f, 0.f, 0.f, 0.f};
    bf16x8 At[4][2], B0[2][2], B1[2][2];
    i32x8 At8[4], B08[2], B18[2];
    int scla = 0x7F7F7F7F, sclb = 0x7F7F7F7F; if constexpr (FP8 || MIXED) { scla = Epi::SCALE_A; sclb = Epi::SCALE_B; }
    const char* cA = cur.A; const char* cB = cur.B;
    G8_STAGE(G8_SB(0, 0), cB, voffB[0], voffB[1]); G8_STAGE(G8_SA(0, 0), cA, va[0][0], va[0][1]); G8_STAGE(G8_SB(0, 1), cB + hstepB, voffB[0], voffB[1]); G8_STAGE(G8_SA(0, 1), cA, va[1][0], va[1][1]);
    if (wr == 1) G8_BAR;
    G8_WAIT_V(4); G8_BAR;
    G8_STAGE(G8_SB(1, 0), cB + kstep, voffB[0], voffB[1]); G8_STAGE(G8_SA(1, 0), cA + kstep, va[0][0], va[0][1]); G8_STAGE(G8_SB(1, 1), cB + hstepB + kstep, voffB[0], voffB[1]);
    G8_WAIT_V(6); G8_BAR;
#define G8_UNIT         const bool has_next = S.next(ui + 1, nxt); \
        const char* nA = has_next ? nxt.A : cA; const char* nB = has_next ? nxt.B : cB; \
        if (GATHER) { \
            if (has_next) { \
_Pragma("unroll") \
                for (int i = 0; i < 2; ++i) { vn[0][i] = (unsigned)nxt.gidx[RA[i]] * lda + (unsigned)CA[i] * 2u; vn[1][i] = (unsigned)nxt.gidx[RA[i] + HALF] * lda + (unsigned)CA[i] * 2u; } \
            } else { \
_Pragma("unroll") \
                for (int i = 0; i < 2; ++i) { vn[0][i] = va[0][i]; vn[1][i] = va[1][i]; } \
            } \
        } \
        const int nt = cur.nt; \
        G8_KLOOP \
        if constexpr (FP8 || MIXED) asm volatile("s_nop 15\n\ts_nop 15\n\ts_nop 15" ::: "memory"); \
        const bool keep = E(acc, cur, wr, wc, fr, fq); \
        if (!has_next) break; \
        if (!keep) { \
_Pragma("unroll") \
            for (int a = 0; a < 2; ++a) \
_Pragma("unroll") \
                for (int b = 0; b < 2; ++b) \
_Pragma("unroll") \
                    for (int m = 0; m < 4; ++m) \
_Pragma("unroll") \
                        for (int n = 0; n < 2; ++n) acc[a][b][m][n] = (f32x4){0.f, 0.f, 0.f, 0.f}; \
        } \
        cur = nxt; cA = nA; cB = nB; ++ui; \
        if (GATHER) { \
_Pragma("unroll") \
            for (int i = 0; i < 2; ++i) { va[0][i] = vn[0][i]; va[1][i] = vn[1][i]; } \
        }
    if constexpr (MIXED) { for (;;) { { constexpr bool f8u = false; (void)f8u; G8_UNIT } { constexpr bool f8u = true; (void)f8u; G8_UNIT } } }
    else { for (;;) { constexpr bool f8u = false; (void)f8u; G8_UNIT } }
    G8_WAIT_V(0);
    if (wr == 0) G8_BAR;
    G8_BAR;
#undef G8_SA
#undef G8_SB
#undef G8_STAGE
#undef G8_LDA
#undef G8_LDB
#undef G8_MMA
#undef G8_KLOOP
#undef G8_UNIT
#undef G8_WAIT_V
#undef G8_WAIT_L
#undef G8_BAR
#undef G8_SCHED
}
}


#define XB_TMO      128
#define XB_XCNT(j)  (256  + 64 * (j))
#define XB_XSUB(j)  (1280 + 64 * (j))
#define XB_XGEN(j)  (2304 + 64 * (j))
#define XB_TOP      3328
#define XB_TOPGEN   3392
#define XCD_BAR_WORDS 3456
#define XB_MODCNT   3600
#define XB_SPIN_CAP (1u << 20)
__device__ __forceinline__ unsigned xb_ld(unsigned* p)              { return __hip_atomic_load(p, __ATOMIC_RELAXED, __HIP_MEMORY_SCOPE_AGENT); }
__device__ __forceinline__ unsigned xb_add(unsigned* p, unsigned v) { return __hip_atomic_fetch_add(p, v, __ATOMIC_RELAXED, __HIP_MEMORY_SCOPE_AGENT); }
__device__ __forceinline__ unsigned xb_xcc_id() { return (unsigned)__builtin_amdgcn_s_getreg((3 << 11) | 20) & 0xFu; }
#define XB_SPIN(cond, bar) do { unsigned _sp = 0; while (cond) { __builtin_amdgcn_s_sleep(1); \
    if ((++_sp & 255u) == 0u) { if (xb_ld(&(bar)[XB_TMO])) break; if (_sp > XB_SPIN_CAP) { atomicAdd(&(bar)[XB_TMO], 1u); break; } } } } while (0)
struct XcdBarrier { unsigned* bar; unsigned x; volatile LAS unsigned* st; };
__device__ __forceinline__ XcdBarrier xcd_barrier_post(unsigned* bar, volatile LAS unsigned* st) {
    XcdBarrier b; b.bar = bar; b.x = xb_xcc_id(); b.st = st;
    if (threadIdx.x == 0) (void)xb_add(&bar[XB_XCNT(b.x)], 1u);
    return b;
}
__device__ __forceinline__ void xcd_barrier_complete(unsigned* bar, unsigned x, unsigned& nloc, unsigned& nx) {
    const unsigned G = gridDim.x * gridDim.y * gridDim.z;
    unsigned sum, cnt, mine, sp = 0u;
    for (;;) {
        sum = 0u; cnt = 0u; mine = 0u;
#pragma unroll
        for (unsigned j = 0; j < 16; ++j) { const unsigned c = xb_ld(&bar[XB_XCNT(j)]); sum += c; cnt += (c > 0u) ? 1u : 0u; mine = (j == x) ? c : mine; }
        if (sum == G) break;
        __builtin_amdgcn_s_sleep(1);
        if ((++sp & 255u) == 0u) { if (xb_ld(&bar[XB_TMO])) break; if (sp > XB_SPIN_CAP) { atomicAdd(&bar[XB_TMO], 1u); break; } }
    }
    nloc = mine > 0u ? mine : 1u; nx = cnt > 0u ? cnt : 1u;
}
__device__ __forceinline__ void xcd_barrier(const XcdBarrier& b) {
    asm volatile("s_waitcnt vmcnt(0)" ::: "memory");
    __syncthreads();
    if (threadIdx.x == 0) {
        unsigned* bar = b.bar;
        __builtin_amdgcn_s_waitcnt(0);
        unsigned nloc = b.st[0], nx = b.st[1];
        if (nloc == 0u) { xcd_barrier_complete(bar, b.x, nloc, nx); b.st[0] = nloc; b.st[1] = nx; }
        const unsigned old = xb_add(&bar[XB_XSUB(b.x)], 1u);
        const unsigned gen = old / nloc;
        if (old + 1u == (gen + 1u) * nloc) {
            __builtin_amdgcn_fence(__ATOMIC_RELEASE, "agent");
            asm volatile("s_waitcnt vmcnt(0)" ::: "memory");
            const unsigned og = xb_add(&bar[XB_TOP], 1u);
            const unsigned tg = og / nx;
            if (og + 1u == (tg + 1u) * nx) xb_add(&bar[XB_TOPGEN], 1u);
            else XB_SPIN(xb_ld(&bar[XB_TOPGEN]) == tg, bar);
            __builtin_amdgcn_fence(__ATOMIC_ACQUIRE, "agent");
            xb_add(&bar[XB_XGEN(b.x)], 1u);
            asm volatile("s_waitcnt vmcnt(0)" ::: "memory");
        } else {
            XB_SPIN(xb_ld(&bar[XB_XGEN(b.x)]) == gen, bar);
            __builtin_amdgcn_fence(__ATOMIC_ACQUIRE, "agent");
            asm volatile("s_waitcnt vmcnt(0)" ::: "memory");
        }
    }
    __syncthreads();
}

__device__ __forceinline__ void phase_mod(const Params& p, int bid, int nblk, char* smem) {
    const int TIDX = otid();
    float* sc = (float*)smem;
    float* red = sc + 9 * 1024;
    const int tid = TIDX;
    { float cv[18];
#pragma unroll
      for (int j = 0; j < 18; ++j) { const int i = tid + NT * j, v = i >> 10, k = i & 1023; cv[j] = v < 8 ? p.c[v * 1024 + k] : p.c_ctx[k]; }
#pragma unroll
      for (int j = 0; j < 18; ++j) sc[tid + NT * j] = siluf(cv[j]); }
    __syncthreads();
    for (int it = bid; it < 192; it += nblk) {
        const int cgp = it % 48, ks = it / 48, c = tid & 127, rl = tid >> 7, j = cgp * 128 + c;
        float acc[9];
#pragma unroll
        for (int v = 0; v < 9; ++v) acc[v] = 0.f;
#pragma unroll 1
        for (int i0 = 0; i0 < 64; i0 += 32) {
            float wv_[32];
#pragma unroll
            for (int i = 0; i < 32; ++i) wv_[i] = p.w_mod[(size_t)(ks * 256 + rl + 4 * (i0 + i)) * 6144 + j];
#pragma unroll
            for (int i = 0; i < 32; ++i) {
                const int k = ks * 256 + rl + 4 * (i0 + i);
#pragma unroll
                for (int v = 0; v < 9; ++v) acc[v] += sc[v * 1024 + k] * wv_[i];
                if ((i & 3) == 3) asm volatile("" ::: "memory");
            }
        }
#pragma unroll
        for (int v = 0; v < 9; ++v) red[(rl * 9 + v) * 128 + c] = acc[v];
        __syncthreads();
        for (int o = tid; o < 9 * 128; o += NT) {
            const int v = o >> 7, cc = o & 127;
            p.pmod[(size_t)(ks * 9 + v) * 6144 + cgp * 128 + cc] = (red[(0 * 9 + v) * 128 + cc] + red[(1 * 9 + v) * 128 + cc]) + (red[(2 * 9 + v) * 128 + cc] + red[(3 * 9 + v) * 128 + cc]);
        }
        __syncthreads();
    }
}
__device__ __forceinline__ f32x4 mod4(const Params& p, int idx) {
    const f32x4 a = *(const f32x4*)(p.pmod + idx), b = *(const f32x4*)(p.pmod + 9 * 6144 + idx), c = *(const f32x4*)(p.pmod + 2 * 9 * 6144 + idx), d = *(const f32x4*)(p.pmod + 3 * 9 * 6144 + idx);
    return ((a + b) + (c + d)) + *(const f32x4*)(p.b_mod + (idx % 6144));
}
__device__ __forceinline__ void phase_modsum(const Params& p, int bid, int nblk) {
    const int tid = otid();
    for (int idx = bid * 216 + tid; idx < (bid + 1) * 216 && idx < 9 * 6144; idx += NT) {
        const float s = (p.pmod[idx] + p.pmod[9 * 6144 + idx]) + (p.pmod[2 * 9 * 6144 + idx] + p.pmod[3 * 9 * 6144 + idx]);
        p.mod[idx] = s + p.b_mod[idx % 6144];
    }
}
__device__ __forceinline__ void phase_modulate(const Params& p, int bid, int nblk, char* smem) {
    const int TIDX = otid();
    const int lane = TIDX & 63;
    float* mvl = (float*)smem;
    { const int v0 = (bid * 64) / SEQ;
      for (int o = TIDX; o < 3 * 512; o += NT) { const int s = o >> 9, k4 = (o & 511) * 4, v = s == 0 ? v0 : (s == 1 ? v0 + 4 : 8); *(f32x4*)(mvl + s * 2048 + k4) = mod4(p, v * 6144 + k4); }
      __syncthreads(); }
    int s_ = 0;
    for (int row8 = (bid * 8 + (TIDX >> 6)) * 8; row8 < NTOK; row8 += nblk * 64, ++s_) {
        const float* src; int v;
        if (row8 < NLAT) { src = p.x + (size_t)row8 * 1024; v = row8 / SEQ; } else { src = p.ctx + (size_t)(row8 - NLAT) * 1024; v = 8; }
        float4 xv[8][4];
#pragma unroll
        for (int r = 0; r < 8; ++r)
#pragma unroll
            for (int i = 0; i < 4; ++i) { const f32x4 t_ = __builtin_nontemporal_load((const f32x4*)(src + r * 1024 + i * 256 + lane * 4)); xv[r][i] = make_float4(t_[0], t_[1], t_[2], t_[3]); }
        f32x4 gn[4], sh[4];
#pragma unroll
        for (int i = 0; i < 4; ++i) { const int k = i * 256 + lane * 4; gn[i] = *(const f32x4*)(p.norm_mix_pre + k); const f32x4 sc = *(const f32x4*)(mvl + s_ * 2048 + 1024 + k); sh[i] = *(const f32x4*)(mvl + s_ * 2048 + k); gn[i] *= (sc + 1.0f); }
#pragma unroll
        for (int r = 0; r < 8; ++r) {
            float ss = 0.f;
#pragma unroll
            for (int i = 0; i < 4; ++i) ss += xv[r][i].x * xv[r][i].x + xv[r][i].y * xv[r][i].y + xv[r][i].z * xv[r][i].z + xv[r][i].w * xv[r][i].w;
            ss = wave_sum(ss);
            const float rstd = rsqrtf(ss * (1.0f / 1024.0f) + RMS_EPS);
            float o[4][4]; float mx = 0.f;
#pragma unroll
            for (int i = 0; i < 4; ++i) {
                o[i][0] = xv[r][i].x * rstd * gn[i][0] + sh[i][0]; o[i][1] = xv[r][i].y * rstd * gn[i][1] + sh[i][1]; o[i][2] = xv[r][i].z * rstd * gn[i][2] + sh[i][2]; o[i][3] = xv[r][i].w * rstd * gn[i][3] + sh[i][3];
                mx = fmaxf(fmaxf(mx, fmaxf(fabsf(o[i][0]), fabsf(o[i][1]))), fmaxf(fabsf(o[i][2]), fabsf(o[i][3])));
            }
            mx = fmaxf(wave_max(mx), 1e-20f);
            const float inv = 127.0f * frcp(mx);
            if (lane == 0) p.hscale[row8 + r] = mx * (1.0f / 127.0f);
#pragma unroll
            for (int i = 0; i < 4; ++i) {
                const int q0 = (int)rintf(o[i][0] * inv), q1 = (int)rintf(o[i][1] * inv), q2 = (int)rintf(o[i][2] * inv), q3 = (int)rintf(o[i][3] * inv);
                *(unsigned*)(p.hq + (size_t)(row8 + r) * 1024 + i * 256 + lane * 4) = (unsigned)(q0 & 255) | ((unsigned)(q1 & 255) << 8) | ((unsigned)(q2 & 255) << 16) | ((unsigned)q3 << 24);
            }
        }
    }
}

struct TrTile { const float* src; bf16_t* dst; int lds_, k0, n0, nvalid, dr0, dc0; size_t ldd; const float* ksc; };
template <class Gen>
__device__ __forceinline__ void tr_stream(const Gen& gen, char* smem) {
    const int TIDX = otid();
    float* tile = (float*)smem;
    const int tid = TIDX, nl = tid & 127, kl = tid >> 7;
    TrTile t0, t1; float v0[16], v1[16];
    auto ld = [&](const TrTile& t, float (&v)[16]) {
#pragma unroll
        for (int i = 0; i < 16; ++i) v[i] = (t.n0 + nl < t.nvalid) ? t.src[(size_t)(t.k0 + kl + 4 * i) * t.lds_ + t.n0 + nl] * (t.ksc ? t.ksc[t.k0 + kl + 4 * i] : 1.0f) : 0.f;
    };
    auto emit = [&](const TrTile& c, const float (&v)[16], float* tb) {
#pragma unroll
        for (int i = 0; i < 16; ++i) tb[(kl + 4 * i) * 129 + nl] = v[i];
        __syncthreads();
#pragma unroll
        for (int i = 0; i < 8; ++i) { const int k2 = (tid & 31) * 2, n = (tid >> 5) + 16 * i;
            *(unsigned*)(c.dst + (size_t)(c.dr0 + n) * c.ldd + c.dc0 + k2) = g8::cvt_pk_bf16(tb[k2 * 129 + n], tb[(k2 + 1) * 129 + n]); }
    };
    bool h0 = gen(0, t0), h1 = gen(1, t1);
    if (h0) ld(t0, v0);
    if (h1) ld(t1, v1);
    for (int it = 0; h0; it += 2) {
        { const TrTile c = t0; emit(c, v0, tile); h0 = gen(it + 2, t0); if (h0) ld(t0, v0); }
        if (!h1) break;
        { const TrTile c = t1; emit(c, v1, tile + 64 * 129); h1 = gen(it + 3, t1); if (h1) ld(t1, v1); }
    }
    __syncthreads();
}
struct GenPrepQ { Params p; int bid, nblk;
    __device__ __forceinline__ bool operator()(int idx, int& kt, int& ntl) const { const int it = idx * nblk + bid; if (it >= 864) return false; kt = it & 15; ntl = it >> 4; return true; } };
__device__ __forceinline__ void tr_stream_q(const Params& p, int bid, int nblk, char* smem) {
    const int TIDX = otid();
    float* tile = (float*)smem;
    const int tid = TIDX, nl = tid & 127, kl = tid >> 7;
    GenPrepQ gen{p, bid, nblk};
    int kt0, nt0, kt1, nt1; float v0[16], v1[16];
    auto ld = [&](int kt, int ntl, float (&v)[16]) {
#pragma unroll
        for (int i = 0; i < 16; ++i) v[i] = (ntl * 128 + nl < P_IN) ? p.w_in[(size_t)(kt * 64 + kl + 4 * i) * P_IN + ntl * 128 + nl] : 0.f;
    };
    auto emit = [&](int kt, int ntl, const float (&v)[16], float* tb) {
#pragma unroll
        for (int i = 0; i < 16; ++i) tb[(kl + 4 * i) * 129 + nl] = v[i];
        __syncthreads();
#pragma unroll
        for (int i = 0; i < 4; ++i) { const int k4 = (tid & 15) * 4, n = (tid >> 4) + 32 * i, ng = ntl * 128 + n;
            const float cm = fmaxf(__uint_as_float(p.colmax[ng]), 1e-20f), inv = 127.0f * frcp(cm);
            const int q0 = (int)rintf(tb[k4 * 129 + n] * inv), q1 = (int)rintf(tb[(k4 + 1) * 129 + n] * inv), q2 = (int)rintf(tb[(k4 + 2) * 129 + n] * inv), q3 = (int)rintf(tb[(k4 + 3) * 129 + n] * inv);
            *(unsigned*)(p.WinQ + (size_t)ng * 1024 + kt * 64 + k4) = (unsigned)(q0 & 255) | ((unsigned)(q1 & 255) << 8) | ((unsigned)(q2 & 255) << 16) | ((unsigned)q3 << 24);
            if (kt == 0 && (tid & 15) == 0) p.wscale[ng] = cm * (1.0f / 127.0f); }
    };
    bool h0 = gen(0, kt0, nt0), h1 = gen(1, kt1, nt1);
    if (h0) ld(kt0, nt0, v0);
    if (h1) ld(kt1, nt1, v1);
    for (int it = 0; h0; it += 2) {
        { const int ck = kt0, cn = nt0; emit(ck, cn, v0, tile); h0 = gen(it + 2, kt0, nt0); if (h0) ld(kt0, nt0, v0); }
        if (!h1) break;
        { const int ck = kt1, cn = nt1; emit(ck, cn, v1, tile + 64 * 129); h1 = gen(it + 3, kt1, nt1); if (h1) ld(kt1, nt1, v1); }
    }
    __syncthreads();
}
__device__ __forceinline__ void phase_winq(const Params& p, int bid, int nblk, char* smem) {
    const int tid = otid(), lane = tid & 63, wv = tid >> 6;
    float* st = (float*)smem;
    float* cmx = st + 1024 * 33;
    for (int s = bid; s < 216; s += nblk) {
        const int n0 = s * 32;
        __syncthreads();
        f32x4 v[16];
#pragma unroll
        for (int i = 0; i < 16; ++i) { const int f = tid + 512 * i, k = f >> 3, c4 = f & 7;
            v[i] = (n0 + c4 * 4 < P_IN) ? __builtin_nontemporal_load((const f32x4*)(p.w_in + (size_t)k * P_IN + n0 + c4 * 4)) : (f32x4){0.f, 0.f, 0.f, 0.f}; }
#pragma unroll
        for (int i = 0; i < 16; ++i) { const int f = tid + 512 * i, k = f >> 3, c4 = f & 7;
#pragma unroll
            for (int j = 0; j < 4; ++j) st[k * 33 + c4 * 4 + j] = v[i][j]; }
        __syncthreads();
#pragma unroll
        for (int cc = 0; cc < 4; ++cc) {
            const int c = 4 * wv + cc; float m = 0.f;
#pragma unroll
            for (int i = 0; i < 16; ++i) m = fmaxf(m, fabsf(st[(lane + 64 * i) * 33 + c]));
            m = wave_max(m);
            if (lane == 0) cmx[c] = fmaxf(m, 1e-20f);
        }
        __syncthreads();
#pragma unroll
        for (int j = 0; j < 4; ++j) {
            const int item = tid + 512 * j, n = item & 31, kc = item >> 5;
            const float cm = cmx[n], inv = 127.0f * frcp(cm);
            unsigned w[4];
#pragma unroll
            for (int g4 = 0; g4 < 4; ++g4) {
                const int k = 16 * kc + 4 * g4;
                const int q0 = (int)rintf(st[k * 33 + n] * inv), q1 = (int)rintf(st[(k + 1) * 33 + n] * inv), q2 = (int)rintf(st[(k + 2) * 33 + n] * inv), q3 = (int)rintf(st[(k + 3) * 33 + n] * inv);
                w[g4] = (unsigned)(q0 & 255) | ((unsigned)(q1 & 255) << 8) | ((unsigned)(q2 & 255) << 16) | ((unsigned)q3 << 24);
            }
            *(u32x4*)(p.WinQ + (size_t)(n0 + n) * 1024 + 16 * kc) = (u32x4){w[0], w[1], w[2], w[3]};
            if (kc == 0) p.wscale[n0 + n] = cm * (1.0f / 127.0f);
        }
    }
    __syncthreads();
}
__device__ __forceinline__ void phase_colmax(const Params& p, int bid, int nblk) {
    const int tid = otid();
    for (int it = bid; it < 128; it += nblk) {
        const float* base = p.w_in + (size_t)it * 8 * P_IN;
#pragma unroll 2
        for (int j = 0; j < 14; ++j) {
            const int n = tid + 512 * j;
            if (n < P_IN) {
                float m = 0.f;
#pragma unroll
                for (int r = 0; r < 8; ++r) m = fmaxf(m, fabsf(base[(size_t)r * P_IN + n]));
                atomicMax(p.colmax + n, __float_as_uint(m));
            }
        }
    }
}
struct GenPrepA { Params p; int bid, nblk;
    __device__ __forceinline__ bool operator()(int idx, TrTile& t) const {
        const int it = idx * nblk + bid + 864; if (it >= 864 + 192) return false;
        if (it < 1056) { const int j = it - 864, kt = j % 24, ntl = j / 24; t = TrTile{p.w_ssd_out, p.WmT, 1024, kt * 64, ntl * 128, 1024, ntl * 128, 1024 + kt * 64, AVLD, p.ssd_norm}; }
        else { const int j = it - 1056, kt = j & 15, ntl = j >> 4; t = TrTile{p.w_out, p.WoT, 1024, kt * 64, ntl * 128, 1024, ntl * 128, kt * 64, 1024, nullptr}; }
        return true;
    } };
__device__ __forceinline__ void phase_prep(const Params& p, int bid, int nblk, char* smem) {
    const int TIDX = otid();
    { GenPrepA g{p, bid, nblk}; tr_stream(g, smem); }
    const int tid = TIDX;
    {
        float2* tab = (float2*)smem;
        if (tid < 128) tab[tid] = make_float2(__builtin_amdgcn_cosf((float)tid * (1.0f / 128.0f)), __builtin_amdgcn_sinf((float)tid * (1.0f / 128.0f)));
        __syncthreads();
#pragma unroll 1
        for (int fb = bid; fb < 256; fb += nblk) {
            const int idx = fb * NT + tid, n = idx & 1023, g = (idx >> 10) & 3, c0 = (fb >> 3) * 4;
            float ac[4], as[4];
#pragma unroll
            for (int j = 0; j < 4; ++j) { ac[j] = 0.f; as[j] = 0.f; }
#pragma unroll 1
            for (int m0 = 0; m0 < 128; m0 += 32) {
                float wv[32];
#pragma unroll
                for (int mm = 0; mm < 32; ++mm) wv[mm] = p.w_fourier[(size_t)(g * 128 + m0 + mm) * 1024 + n];
#pragma unroll
                for (int mm = 0; mm < 32; ++mm) {
                    const int m = m0 + mm;
#pragma unroll
                    for (int j = 0; j < 4; ++j) { const float2 cs = tab[(m * (c0 + j)) & 127]; ac[j] += cs.x * wv[mm]; as[j] += cs.y * wv[mm]; }
                    if ((mm & 7) == 7) asm volatile("" ::: "memory");
                }
            }
            unsigned char* d0 = (unsigned char*)p.WmT + (size_t)n * (AVLD * 2) + g * 128 + c0;
            { int pc_ = __builtin_amdgcn_cvt_pk_fp8_f32(clamp8(8.f * ac[0]), clamp8(8.f * ac[1]), 0, false); pc_ = __builtin_amdgcn_cvt_pk_fp8_f32(clamp8(8.f * ac[2]), clamp8(8.f * ac[3]), pc_, true);
              int ps_ = __builtin_amdgcn_cvt_pk_fp8_f32(clamp8(-8.f * as[0]), clamp8(-8.f * as[1]), 0, false); ps_ = __builtin_amdgcn_cvt_pk_fp8_f32(clamp8(-8.f * as[2]), clamp8(-8.f * as[3]), ps_, true);
              *(int*)d0 = pc_; *(int*)(d0 + 512) = ps_; }
        }
        __syncthreads();
    }
}
__device__ __forceinline__ void phase_dmat(const Params& p, int bid, int nblk) {
    const int tid = otid();
    for (int it = bid; it < 1024; it += nblk) {
        {
            const int idx = it * NT + tid, r = idx >> 7, l0 = (idx & 127) * 16;
            const int rr = r & 2047, sh = r < 2048 ? 0 : 1024;
            unsigned w[4];
#pragma unroll
            for (int j = 0; j < 4; ++j) {
                unsigned pk = 0u;
#pragma unroll
                for (int e = 0; e < 4; ++e) { const int ph = ((rr * (l0 + 4 * j + e)) - sh) & 4095; const int qv = (int)rintf(127.0f * __builtin_amdgcn_cosf((float)ph * (1.0f / 4096.0f))); pk |= ((unsigned)qv & 255u) << (8 * e); }
                w[j] = pk; }
            *(u32x4*)(p.dmat + (size_t)r * 2048 + l0) = (u32x4){w[0], w[1], w[2], w[3]};
        }
    }
}
struct TrTile8 { const float* src; unsigned char* dst; int k0, n0, dr0; };
template <class Gen>
__device__ __forceinline__ void tr_stream8(const Gen& gen, char* smem) {
    constexpr int D = 6;
    typedef float f32x2 __attribute__((ext_vector_type(2)));
    const int TIDX = otid();
    float* tile = (float*)smem;
    const int tid = TIDX, n2 = tid & 63, kl = tid >> 6;
    TrTile8 t[D]; f32x2 v[D][8]; bool h[D];
    auto ld = [&](const TrTile8& tt, f32x2 (&vv)[8]) {
#pragma unroll
        for (int i = 0; i < 8; ++i) vv[i] = __builtin_nontemporal_load((const f32x2*)(tt.src + (size_t)(tt.k0 + kl + 8 * i) * 1024 + tt.n0 + 2 * n2));
    };
    auto emit = [&](const TrTile8& c, const f32x2 (&vv)[8], float* tb) {
#pragma unroll
        for (int i = 0; i < 8; ++i) { tb[(kl + 8 * i) * 129 + 2 * n2] = vv[i][0]; tb[(kl + 8 * i) * 129 + 2 * n2 + 1] = vv[i][1]; }
        __syncthreads();
        const int n = tid >> 2, k16 = (tid & 3) * 16;
        unsigned w[4];
#pragma unroll
        for (int j = 0; j < 4; ++j) {
            int pk = __builtin_amdgcn_cvt_pk_fp8_f32(clamp8(64.f * tb[(k16 + 4 * j) * 129 + n]), clamp8(64.f * tb[(k16 + 4 * j + 1) * 129 + n]), 0, false);
            pk = __builtin_amdgcn_cvt_pk_fp8_f32(clamp8(64.f * tb[(k16 + 4 * j + 2) * 129 + n]), clamp8(64.f * tb[(k16 + 4 * j + 3) * 129 + n]), pk, true);
            w[j] = (unsigned)pk; }
        *(u32x4*)(c.dst + (size_t)(c.dr0 + n) * 1024 + c.k0 + k16) = (u32x4){w[0], w[1], w[2], w[3]};
    };
#pragma unroll
    for (int s = 0; s < D; ++s) { h[s] = gen(s, t[s]); if (h[s]) ld(t[s], v[s]); }
    for (int it = 0; h[0]; it += D) {
#pragma unroll
        for (int s = 0; s < D; ++s) {
            if (h[s]) { const TrTile8 c = t[s]; emit(c, v[s], tile + (s & 1) * 64 * 129); h[s] = gen(it + D + s, t[s]); if (h[s]) ld(t[s], v[s]); }
        }
    }
    __syncthreads();
}
struct GenPrepB8 { Params p; int bid, nblk, lo, hi;
    __device__ __forceinline__ bool operator()(int idx, TrTile8& t) const {
        const int it = lo + idx * nblk + bid; if (it >= hi) return false;
        const int which = it >> 11, j = it & 2047, e = j >> 7, kt = j & 15, ntl = (j >> 4) & 7, n0 = ntl * 128;
        if (which == 0) t = TrTile8{p.w_e_gate + (size_t)e * 1048576, p.WguT8, kt * 64, n0, e * 2048 + ntl * 256};
        else if (which == 1) t = TrTile8{p.w_e_up + (size_t)e * 1048576, p.WguT8, kt * 64, n0, e * 2048 + ntl * 256 + 128};
        else t = TrTile8{p.w_e_down + (size_t)e * 1048576, p.WdT8, kt * 64, n0, e * 1024 + n0};
        return true;
    } };
struct GenPrepO8 { Params p; int bid, nblk;
    __device__ __forceinline__ bool operator()(int idx, TrTile8& t) const {
        const int it = idx * nblk + bid; if (it >= 128) return false;
        const int kt = it & 15, ntl = it >> 4; t = TrTile8{p.w_out, p.WoT8, kt * 64, ntl * 128, ntl * 128}; return true;
    } };
__device__ __forceinline__ void phase_prep2(const Params& p, int bid, int nblk, int lo, int hi, char* smem) {
    __syncthreads();
    GenPrepB8 g{p, bid, nblk, lo, hi}; tr_stream8(g, smem);
}
__device__ __forceinline__ u32x4 pack8(const f32x4 v0, const f32x4 v1) { return (u32x4){g8::cvt_pk_bf16(v0[0], v0[1]), g8::cvt_pk_bf16(v0[2], v0[3]), g8::cvt_pk_bf16(v1[0], v1[1]), g8::cvt_pk_bf16(v1[2], v1[3])}; }
__device__ __forceinline__ void unpack8(const u32x4 w, float (&o)[8]) {
#pragma unroll
    for (int j = 0; j < 4; ++j) { o[2 * j] = __uint_as_float(w[j] << 16); o[2 * j + 1] = __uint_as_float(w[j] & 0xffff0000u); }
}
struct SchedInProj { const char* A; const char* B; int G, c;
    __device__ __forceinline__ bool next(int i, g8::Unit& u) const {
        const int L = i * G + c; int pm, pn;
        if (L < 3456) g8::grid_map(L, 128, 27, pm, pn);
        else if (L < 3544) { const int L2 = L - 3456; pm = 128 + (L2 & 7); pn = 8 + (L2 >> 3); }
        else return false;
        u.A = A + (size_t)pm * 256 * 1024; u.B = B + (size_t)pn * 256 * 1024; u.gidx = nullptr; u.nt = 8; u.pm = pm; u.pn = pn; u.aux = 0;
        if (pn < 2) { const char* t = u.A; u.A = u.B; u.B = t; }
        return true;
    } };
__device__ __forceinline__ float dpp_ror1(float v) { return __int_as_float(__builtin_amdgcn_update_dpp(0, __float_as_int(v), 0x121, 0xF, 0xF, false)); }
__device__ __forceinline__ float dpp_ror15(float v) { return __int_as_float(__builtin_amdgcn_update_dpp(0, __float_as_int(v), 0x12F, 0xF, 0xF, false)); }
struct EpiInProj { static constexpr bool PERM = true; Params p; LAS unsigned char* lds;
    __device__ __forceinline__ bool operator()(f32x4 (&acc)[2][2][4][2], const g8::Unit& u, int wr, int wc, int fr, int fq) const {
        const int row0 = u.pm * 256 + wr * 64 + fr;
        {
            const bool sw = u.pn < 2;
            const float* rsc = sw ? p.wscale + u.pn * 256 + wr * 64 + fr : p.hscale + row0;
            const float* csc = sw ? p.hscale + u.pm * 256 + wc * 32 + fq * 8 : p.wscale + u.pn * 256 + wc * 32 + fq * 8;
            float sa[2][4];
#pragma unroll
            for (int ai = 0; ai < 2; ++ai)
#pragma unroll
                for (int m = 0; m < 4; ++m) sa[ai][m] = rsc[ai * 128 + m * 16];
#pragma unroll
            for (int bj = 0; bj < 2; ++bj) {
                const f32x4 s0 = *(const f32x4*)(csc + bj * 128), s1 = *(const f32x4*)(csc + bj * 128 + 4);
#pragma unroll
                for (int ai = 0; ai < 2; ++ai)
#pragma unroll
                    for (int m = 0; m < 4; ++m)
#pragma unroll
                        for (int j = 0; j < 4; ++j) { acc[ai][bj][m][0][j] = (float)__float_as_int(acc[ai][bj][m][0][j]) * (sa[ai][m] * s0[j]); acc[ai][bj][m][1][j] = (float)__float_as_int(acc[ai][bj][m][1][j]) * (sa[ai][m] * s1[j]); }
            }
        }
        if (u.pn < 2) {
            bf16_t* base = p.ufT + (size_t)((u.pm >> 4) * 512 + u.pn * 256 + wr * 64 + fr) * 4096 + (u.pm & 15) * 256 + wc * 32 + fq * 8;
#pragma unroll
            for (int ai = 0; ai < 2; ++ai)
#pragma unroll
                for (int m = 0; m < 4; ++m)
#pragma unroll
                    for (int bj = 0; bj < 2; ++bj) *(u32x4*)(base + (size_t)(ai * 128 + m * 16) * 4096 + bj * 128) = pack8(acc[ai][bj][m][0], acc[ai][bj][m][1]);
            return false;
        }
        if (u.pn >= 8 && u.pn < 18 && u.pm < 128) {
#pragma unroll
            for (int bj = 0; bj < 2; ++bj) {
                const int ch0 = u.pn * 256 + bj * 128 + wc * 32 + fq * 8 - 2048;
                float cwv[8][4];
#pragma unroll
                for (int i = 0; i < 4; ++i) { const u32x4 tv = *(const LAS u32x4*)(lds + CONVT_OFF + ch0 * 8 + 16 * i);
                    cwv[2 * i][0] = __uint_as_float(tv[0] << 16); cwv[2 * i][1] = __uint_as_float(tv[0] & 0xffff0000u); cwv[2 * i][2] = __uint_as_float(tv[1] << 16); cwv[2 * i][3] = __uint_as_float(tv[1] & 0xffff0000u);
                    cwv[2 * i + 1][0] = __uint_as_float(tv[2] << 16); cwv[2 * i + 1][1] = __uint_as_float(tv[2] & 0xffff0000u); cwv[2 * i + 1][2] = __uint_as_float(tv[3] << 16); cwv[2 * i + 1][3] = __uint_as_float(tv[3] & 0xffff0000u); }
#pragma unroll
                for (int ai = 0; ai < 2; ++ai) {
                    unsigned pk[4][4];
#pragma unroll
                    for (int jp = 0; jp < 4; ++jp) {
                        float o[4][2];
#pragma unroll
                        for (int h = 0; h < 2; ++h) {
                            const int j = 2 * jp + h;
                            const float w0 = cwv[j][0], w1 = cwv[j][1], w2 = cwv[j][2], bb = cwv[j][3];
                            float uu[4], r1[4], l1[4];
#pragma unroll
                            for (int m = 0; m < 4; ++m) { uu[m] = acc[ai][bj][m][j >> 2][j & 3]; r1[m] = dpp_ror1(uu[m]); l1[m] = dpp_ror15(uu[m]); }
#pragma unroll
                            for (int m = 0; m < 4; ++m) {
                                const float up = fr > 0 ? r1[m] : (m > 0 ? r1[m > 0 ? m - 1 : 0] : 0.f);
                                const float dn = fr < 15 ? l1[m] : (m < 3 ? l1[m < 3 ? m + 1 : 3] : 0.f);
                                o[m][h] = siluf(w0 * up + w1 * uu[m] + w2 * dn + bb);
                            }
                        }
#pragma unroll
                        for (int m = 0; m < 4; ++m) pk[m][jp] = g8::cvt_pk_bf16(o[m][0], o[m][1]);
                    }
#pragma unroll
                    for (int m = 0; m < 4; ++m) *(u32x4*)(p.xbc + (size_t)(row0 + ai * 128 + m * 16) * CONV_CH + ch0) = (u32x4){pk[m][0], pk[m][1], pk[m][2], pk[m][3]};
                }
                asm volatile("" ::: "memory");
            }
            return false;
        }
#pragma unroll
        for (int bj = 0; bj < 2; ++bj) {
            const int n0 = u.pn * 256 + bj * 128 + wc * 32 + fq * 8;
            if (n0 >= 4608 && n0 < 4656) {
#pragma unroll
                for (int ai = 0; ai < 2; ++ai)
#pragma unroll
                    for (int m = 0; m < 4; ++m) { float* q = p.dtraw + (size_t)(row0 + ai * 128 + m * 16) * 48 + (n0 - 4608); *(f32x4*)q = acc[ai][bj][m][0]; *(f32x4*)(q + 4) = acc[ai][bj][m][1]; }
            } else if (n0 < P_IN) {
                auto st = [&](bf16_t* base, size_t ld) {
#pragma unroll
                    for (int ai = 0; ai < 2; ++ai)
#pragma unroll
                        for (int m = 0; m < 4; ++m) *(u32x4*)(base + (size_t)(row0 + ai * 128 + m * 16) * ld) = pack8(acc[ai][bj][m][0], acc[ai][bj][m][1]);
                };
                if (n0 < 2048) { if (u.pm < 128) {
#pragma unroll
                        for (int ai = 0; ai < 2; ++ai)
#pragma unroll
                            for (int m = 0; m < 4; ++m) { f32x4 s0, s1;
#pragma unroll
                                for (int j = 0; j < 4; ++j) { s0[j] = siluf(acc[ai][bj][m][0][j]); s1[j] = siluf(acc[ai][bj][m][1][j]); }
                                *(u32x4*)(p.z + (n0 - 512) + (size_t)(row0 + ai * 128 + m * 16) * 1536) = pack8(s0, s1); } } }
                else if (n0 < 4608) st(p.xbc + (n0 - 2048), 2560);
                else if (u.pm < 128) {
                    const int gcol = n0 - 4656, br = gcol >> 10, c8 = (gcol & 1023) >> 3;
                    const f32x4 b0 = *(const f32x4*)(p.b_gate + gcol), b1 = *(const f32x4*)(p.b_gate + gcol + 4);
#pragma unroll
                    for (int ai = 0; ai < 2; ++ai)
#pragma unroll
                        for (int m = 0; m < 4; ++m) {
                            unsigned w0 = 0, w1 = 0;
#pragma unroll
                            for (int j = 0; j < 4; ++j) { w0 |= (unsigned)__builtin_rintf(255.0f * sigmoidf(acc[ai][bj][m][0][j] + b0[j])) << (8 * j); w1 |= (unsigned)__builtin_rintf(255.0f * sigmoidf(acc[ai][bj][m][1][j] + b1[j])) << (8 * j); }
                            *(u32x2*)(p.gq + (size_t)(row0 + ai * 128 + m * 16) * 2048 + c8 * 16 + br * 8) = (u32x2){w0, w1};
                        }
                }
            }
        }
        return false;
    } };
struct SchedDft { const char* A; const char* Be; const char* Bo; int c;
    __device__ __forceinline__ bool next(int i, g8::Unit& u) const {
        if (c < 0 || i >= 4) return false;
        const int pn = c >> 2, q = c & 3, pm = 4 * q + i;
        u.A = A + (size_t)pm * 256 * 2048; u.B = (q < 2 ? Be : Bo) + (size_t)pn * 256 * 2048; u.gidx = nullptr; u.nt = 16; u.pm = pm; u.pn = pn; u.aux = 0; return true;
    } };
struct EpiDft { static constexpr bool PERM = true; Params p;
    __device__ __forceinline__ bool operator()(const f32x4 (&acc)[2][2][4][2], const g8::Unit& u, int wr, int wc, int fr, int fq) const {
        const int b = u.pn >> 1;
#pragma unroll
        for (int bj = 0; bj < 2; ++bj) {
            const int ch0 = (u.pn & 1) * 256 + bj * 128 + wc * 32 + fq * 8, col = u.pn * 256 + bj * 128 + wc * 32 + fq * 8;
            unsigned char* vb = (unsigned char*)p.av + (size_t)b * 4096 * (AVLD * 2) + ch0;
            auto pk8 = [](const f32x4 a, const f32x4 b_) -> u32x2 { int p0 = __builtin_amdgcn_cvt_pk_fp8_f32(clamp8(0.03125f * a[0]), clamp8(0.03125f * a[1]), 0, false); p0 = __builtin_amdgcn_cvt_pk_fp8_f32(clamp8(0.03125f * a[2]), clamp8(0.03125f * a[3]), p0, true);
                int p1 = __builtin_amdgcn_cvt_pk_fp8_f32(clamp8(0.03125f * b_[0]), clamp8(0.03125f * b_[1]), 0, false); p1 = __builtin_amdgcn_cvt_pk_fp8_f32(clamp8(0.03125f * b_[2]), clamp8(0.03125f * b_[3]), p1, true); return (u32x2){(unsigned)p0, (unsigned)p1}; };
            f32x4 um0 = (f32x4){0.f, 0.f, 0.f, 0.f}, um1 = um0;
            if (u.pm < 8) { um0 = *(const f32x4*)(p.umid + col); um1 = *(const f32x4*)(p.umid + col + 4); }
            const float* usc = (u.pm < 8 ? p.use : p.uso) + col;
            const f32x4 cs0 = *(const f32x4*)usc * (1.0f / 127.0f), cs1 = *(const f32x4*)(usc + 4) * (1.0f / 127.0f);
#pragma unroll
            for (int ai = 0; ai < 2; ++ai)
#pragma unroll
                for (int m = 0; m < 4; ++m) {
                    const int r = u.pm * 256 + ai * 128 + wr * 64 + m * 16 + fr;
                    f32x4 v0, v1;
#pragma unroll
                    for (int j = 0; j < 4; ++j) { v0[j] = (float)__float_as_int(acc[ai][bj][m][0][j]) * cs0[j]; v1[j] = (float)__float_as_int(acc[ai][bj][m][1][j]) * cs1[j]; }
                    if (r < 2048) {
                        const float sg = (r & 1) ? -1.0f : 1.0f;
                        const u32x2 w = pk8(v0 + sg * um0, v1 + sg * um1);
                        *(u32x2*)(vb + (size_t)r * (AVLD * 2)) = w;
                        if (r >= 1) *(u32x2*)(vb + (size_t)(4096 - r) * (AVLD * 2)) = w;
                        if (r == 0) {
                            const f32x4 a0 = *(const f32x4*)(p.ualt + col), a1 = *(const f32x4*)(p.ualt + col + 4);
                            *(u32x2*)(vb + (size_t)2048 * (AVLD * 2)) = pk8(a0, a1);
                            *(u32x2*)(vb + (size_t)2048 * (AVLD * 2) + 512) = (u32x2){0u, 0u};
                        }
                    } else {
                        const int k = r - 2048;
                        *(u32x2*)(vb + (size_t)k * (AVLD * 2) + 512) = pk8(v0, v1);
                        if (k >= 1) *(u32x2*)(vb + (size_t)(4096 - k) * (AVLD * 2) + 512) = pk8(-v0, -v1);
                    }
                }
        }
        return false;
    } };
__device__ __forceinline__ void dft_evenodd(const Params& p, int c) {
    const int tid = otid(), lane = tid & 63, wv = tid >> 6, pn = c >> 2; const bool odd = (c & 3) >= 2;
    for (int rr = 0; rr < 32; ++rr) {
        const int row = pn * 256 + wv * 32 + rr;
        const bf16_t* u = p.ufT + (size_t)row * 4096;
        signed char* dst = (odd ? p.uoT : p.ueT) + (size_t)row * 2048;
        float alt = 0.f; float oo[4][8]; float amx = 0.f;
#pragma unroll
        for (int ci = 0; ci < 4; ++ci) {
            const int jc = lane + 64 * ci;
            float d[8], ma[8], mb[8];
            unpack8(*(const u32x4*)(u + 8 * jc), d);
            unpack8(*(const u32x4*)(u + 4088 - 8 * jc), ma);
            unpack8(jc ? *(const u32x4*)(u + 4096 - 8 * jc) : (u32x4){0u, 0u, 0u, 0u}, mb);
            float* o = oo[ci];
            o[0] = odd ? (jc ? d[0] - mb[0] : 0.f) : d[0] + mb[0];
#pragma unroll
            for (int i = 1; i < 8; ++i) o[i] = odd ? d[i] - ma[8 - i] : d[i] + ma[8 - i];
#pragma unroll
            for (int i = 0; i < 8; ++i) amx = fmaxf(amx, fabsf(o[i]));
            alt += ((o[0] - o[1]) + (o[2] - o[3])) + ((o[4] - o[5]) + (o[6] - o[7]));
        }
        amx = fmaxf(wave_max(amx), 1e-20f);
        { const float inv = 127.0f * frcp(amx);
#pragma unroll
          for (int ci = 0; ci < 4; ++ci) { const int jc = lane + 64 * ci; unsigned w2[2];
#pragma unroll
            for (int h = 0; h < 2; ++h) { unsigned pk = 0u;
#pragma unroll
                for (int e = 0; e < 4; ++e) pk |= ((unsigned)(int)rintf(oo[ci][4 * h + e] * inv) & 255u) << (8 * e);
                w2[h] = pk; }
            *(u32x2*)(dst + 8 * jc) = (u32x2){w2[0], w2[1]}; }
          if (lane == 0) (odd ? p.uso : p.use)[row] = amx * (1.0f / 127.0f); }
        if (!odd) {
            alt = wave_sum(alt);
            const float mid = bf2f(u[2048]);
            if (lane == 0) { p.umid[row] = mid; p.ualt[row] = alt + mid; }
        }
    }
    asm volatile("s_waitcnt vmcnt(0)" ::: "memory");
    __syncthreads();
}
struct SchedMerged { const char* A; const char* B; int G, c;
    __device__ __forceinline__ bool next(int i, g8::Unit& u) const {
        const int L = (i >> 1) * G + c; if (L >= 512) return false; int pm, pn; g8::grid_map(L, 128, 4, pm, pn); const int seg = i & 1;
        u.A = A + (size_t)pm * 256 * (AVLD * 2) + (seg ? 0 : 2048); u.B = B + (size_t)pn * 256 * (AVLD * 2) + (seg ? 0 : 2048);
        u.gidx = nullptr; u.nt = seg ? 8 : 24; u.pm = pm; u.pn = pn; u.aux = seg | ((i >> 1) << 1); return true;
    } };
struct EpiMerged { static constexpr bool PERM = true; static constexpr int SCALE_A = 0x84848484, SCALE_B = 0x7C7C7C7C; Params p; LAS unsigned char* lds;
    __device__ __forceinline__ bool operator()(f32x4 (&acc)[2][2][4][2], const g8::Unit& u, int wr, int wc, int fr, int fq) const {
        const int row0 = u.pm * 256 + wr * 64 + fr, seg = u.aux & 1;
        const LAS float* rs = (const LAS float*)(lds + MERGED_RS_OFF) + (u.aux >> 1) * 256 + wr * 64 + fr;
#pragma unroll
        for (int bj = 0; bj < 2; ++bj) {
            const int c0 = u.pn * 256 + bj * 128 + wc * 32 + fq * 8;
            u32x4 gvall[2][4];
#pragma unroll
            for (int ai = 0; ai < 2; ++ai)
#pragma unroll
                for (int m = 0; m < 4; ++m) gvall[ai][m] = *(const u32x4*)(p.gq + (size_t)(row0 + ai * 128 + m * 16) * 2048 + (c0 >> 3) * 16);
#pragma unroll
            for (int ai = 0; ai < 2; ++ai) {
                const u32x4 (&gv)[4] = gvall[ai];
#pragma unroll
                for (int m = 0; m < 4; ++m) {
                    const size_t row = (size_t)(row0 + ai * 128 + m * 16);
                    float g0[8], g1[8];
#pragma unroll
                    for (int j = 0; j < 4; ++j) { g0[j] = fmaxf((float)((gv[m][0] >> (8 * j)) & 255u), 1.0f) * (1.0f / 255.0f); g0[4 + j] = fmaxf((float)((gv[m][1] >> (8 * j)) & 255u), 1.0f) * (1.0f / 255.0f);
                                                  g1[j] = (float)((gv[m][2] >> (8 * j)) & 255u) * (1.0f / 255.0f); g1[4 + j] = (float)((gv[m][3] >> (8 * j)) & 255u) * (1.0f / 255.0f); }
                    if (seg == 0) {
                        const float rstd = rs[ai * 128 + m * 16];
#pragma unroll
                        for (int j = 0; j < 8; ++j) acc[ai][bj][m][j >> 2][j & 3] *= (rstd * 724.0773439350247f) * g1[j] * frcp(g0[j]);
                    } else {
                        f32x4 v0 = acc[ai][bj][m][0], v1 = acc[ai][bj][m][1];
#pragma unroll
                        for (int j = 0; j < 4; ++j) { v0[j] *= g0[j] * 0.0013810679320049757f; v1[j] *= g0[4 + j] * 0.0013810679320049757f; }
                        { int p0 = __builtin_amdgcn_cvt_pk_fp8_f32(clamp8(4.0f * v0[0]), clamp8(4.0f * v0[1]), 0, false); p0 = __builtin_amdgcn_cvt_pk_fp8_f32(clamp8(4.0f * v0[2]), clamp8(4.0f * v0[3]), p0, true);
                          int p1 = __builtin_amdgcn_cvt_pk_fp8_f32(clamp8(4.0f * v1[0]), clamp8(4.0f * v1[1]), 0, false); p1 = __builtin_amdgcn_cvt_pk_fp8_f32(clamp8(4.0f * v1[2]), clamp8(4.0f * v1[3]), p1, true);
                          *(u32x2*)(p.merged8 + row * 1024 + c0) = (u32x2){(unsigned)p0, (unsigned)p1}; }
                    }
                }
            }
            asm volatile("" ::: "memory");
        }
        return seg == 0;
    } };
__device__ __forceinline__ void merged_prologue(const Params& p, int bid, int nblk, LAS unsigned char* lds) {
    const int tid = otid(), slot = tid >> 8, rl = tid & 255, L = slot * nblk + bid;
    if (L < 512) {
        int pm, pn; g8::grid_map(L, 128, 4, pm, pn);
        const f32x4* q4 = (const f32x4*)(p.ssq + (size_t)(pm * 256 + rl) * NHEADS);
        float sum = 0.f;
#pragma unroll
        for (int i = 0; i < 6; ++i) { const f32x4 v = q4[i]; sum += (v[0] + v[1]) + (v[2] + v[3]); }
        ((LAS float*)(lds + MERGED_RS_OFF))[slot * 256 + rl] = rsqrtf(sum * (1.0f / D_INNER) + RMS_EPS);
    }
    __syncthreads();
}
struct SchedWOut { const char* A; const char* B; int G, c;
    __device__ __forceinline__ bool next(int i, g8::Unit& u) const {
        const int L = i * G + c; if (L >= 512) return false; int pm, pn; g8::grid_map(L, 128, 4, pm, pn);
        u.A = A + (size_t)pm * 256 * 1024; u.B = B + (size_t)pn * 256 * 1024; u.gidx = nullptr; u.nt = 8; u.pm = pm; u.pn = pn; u.aux = 0; return true;
    } };
struct EpiWOut { static constexpr bool PERM = true; static constexpr int SCALE_A = 0x7D7D7D7D, SCALE_B = 0x79797979; Params p;
    __device__ __forceinline__ bool operator()(const f32x4 (&acc)[2][2][4][2], const g8::Unit& u, int wr, int wc, int fr, int fq) const {
        const int row0 = u.pm * 256 + wr * 64 + fr;
#pragma unroll
        for (int ai = 0; ai < 2; ++ai)
#pragma unroll
            for (int m = 0; m < 4; ++m)
#pragma unroll
                for (int bj = 0; bj < 2; ++bj) *(u32x4*)(p.mix + (size_t)(row0 + ai * 128 + m * 16) * 1024 + u.pn * 256 + bj * 128 + wc * 32 + fq * 8) = pack8(acc[ai][bj][m][0], acc[ai][bj][m][1]);
        return false;
    } };
struct SchedExpUp { const char* A; const char* B; const int* topidx; int G, c;
    __device__ __forceinline__ bool next(int i, g8::Unit& u) const {
        if (i >= 2048 / G) return false;
        const int u_ = i * (G >> 3) + (c >> 3), e = 2 * (c & 7) + (u_ >> 7), pn = (u_ >> 4) & 7, rm = u_ & 15, b = rm >> 1, pml = rm & 1, be = b * 16 + e;
        u.A = A + (size_t)b * 4096 * 1024; u.B = B + ((size_t)e * 2048 + pn * 256) * 1024; u.gidx = topidx + be * CAP + pml * 256; u.nt = 8; u.pm = be * 2 + pml; u.pn = pn; u.aux = 0; return true;
    } };
struct EpiExpUp { static constexpr bool PERM = true; static constexpr int SCALE_A = 0x7F7F7F7F, SCALE_B = 0x79797979; Params p;
    __device__ __forceinline__ bool operator()(const f32x4 (&acc)[2][2][4][2], const g8::Unit& u, int wr, int wc, int fr, int fq) const {
        const int row0 = u.pm * 256 + wr * 64 + fr;
#pragma unroll
        for (int ai = 0; ai < 2; ++ai)
#pragma unroll
            for (int m = 0; m < 4; ++m) {
                float v[8];
#pragma unroll
                for (int j = 0; j < 8; ++j) v[j] = clamp8(4.0f * siluf(acc[ai][0][m][j >> 2][j & 3]) * acc[ai][1][m][j >> 2][j & 3]);
                int p0 = __builtin_amdgcn_cvt_pk_fp8_f32(v[0], v[1], 0, false); p0 = __builtin_amdgcn_cvt_pk_fp8_f32(v[2], v[3], p0, true);
                int p1 = __builtin_amdgcn_cvt_pk_fp8_f32(v[4], v[5], 0, false); p1 = __builtin_amdgcn_cvt_pk_fp8_f32(v[6], v[7], p1, true);
                *(u32x2*)(p.hid8 + (size_t)(row0 + ai * 128 + m * 16) * 1024 + u.pn * 128 + wc * 32 + fq * 8) = (u32x2){(unsigned)p0, (unsigned)p1};
            }
        return false;
    } };
struct SchedExpDown { const char* A; const char* B; int G, c;
    __device__ __forceinline__ bool next(int i, g8::Unit& u) const {
        if (i >= 1024 / G) return false;
        const int u_ = i * (G >> 3) + (c >> 3), e = 2 * (c & 7) + (u_ >> 6), pn = (u_ >> 4) & 3, rm = u_ & 15, b = rm >> 1, pml = rm & 1, be = b * 16 + e;
        u.A = A + ((size_t)be * CAP + pml * 256) * 1024; u.B = B + ((size_t)e * 1024 + pn * 256) * 1024; u.gidx = nullptr; u.nt = 8; u.pm = be * 2 + pml; u.pn = pn; u.aux = 0; return true;
    } };
struct EpiExpDown { static constexpr bool PERM = true; static constexpr int SCALE_A = 0x7D7D7D7D, SCALE_B = 0x79797979; Params p;
    __device__ __forceinline__ bool operator()(const f32x4 (&acc)[2][2][4][2], const g8::Unit& u, int wr, int wc, int fr, int fq) const {
        const int row0 = u.pm * 256 + wr * 64 + fr;
        float tav[2][4];
#pragma unroll
        for (int ai = 0; ai < 2; ++ai)
#pragma unroll
            for (int m = 0; m < 4; ++m) tav[ai][m] = p.topaff[row0 + ai * 128 + m * 16];
#pragma unroll
        for (int ai = 0; ai < 2; ++ai)
#pragma unroll
            for (int m = 0; m < 4; ++m) {
                const int row = row0 + ai * 128 + m * 16; const float ta = tav[ai][m];
#pragma unroll
                for (int bj = 0; bj < 2; ++bj) { const f32x4 a0 = acc[ai][bj][m][0] * (64.0f * ta), a1 = acc[ai][bj][m][1] * (64.0f * ta);
                    int p0 = __builtin_amdgcn_cvt_pk_fp8_f32(clamp8(a0[0]), clamp8(a0[1]), 0, false); p0 = __builtin_amdgcn_cvt_pk_fp8_f32(clamp8(a0[2]), clamp8(a0[3]), p0, true);
                    int p1 = __builtin_amdgcn_cvt_pk_fp8_f32(clamp8(a1[0]), clamp8(a1[1]), 0, false); p1 = __builtin_amdgcn_cvt_pk_fp8_f32(clamp8(a1[2]), clamp8(a1[3]), p1, true);
                    *(u32x2*)(p.ye8 + (size_t)row * 1024 + u.pn * 256 + bj * 128 + wc * 32 + fq * 8) = (u32x2){(unsigned)p0, (unsigned)p1}; }
            }
        return false;
    } };

#define SSD_BN 0
#define SSD_CN 16384
#define SSD_XN 32768
#define SSD_HN 40960
#define SSD_VEC 73728
#define SSD_DIRSZ 76800
typedef short s16x4 __attribute__((ext_vector_type(4)));
template <int N> struct IC { static constexpr int value = N; };
__device__ __forceinline__ unsigned ssd_offb(int row, int ch) { return 256u * (unsigned)row + 16u * (unsigned)(ch ^ (((row & 3) << 2) | ((row >> 2) & 3))); }
__device__ __forceinline__ unsigned ssd_offx(int row, int seg) { return 128u * (unsigned)row + 32u * (unsigned)(seg ^ ((row >> 1) & 3)); }
__device__ __forceinline__ s16x4 ssd_tr(unsigned addr) { s16x4 r; asm volatile("ds_read_b64_tr_b16 %0, %1" : "=&v"(r) : "v"(addr) : "memory"); return r; }
__device__ __forceinline__ float bfu(short v) { return __uint_as_float(((unsigned)(unsigned short)v) << 16); }
__device__ __forceinline__ bf16x8 ssd_pack8(const float (&m)[8]) {
    union { u32x4 u; bf16x8 b; } cv; cv.u = (u32x4){g8::cvt_pk_bf16(m[0], m[1]), g8::cvt_pk_bf16(m[2], m[3]), g8::cvt_pk_bf16(m[4], m[5]), g8::cvt_pk_bf16(m[6], m[7])}; return cv.b;
}
__device__ __forceinline__ void phase_ssd(const Params& p, int bid, int nblk, char* smem) {
    if (bid >= 192) return;
    const int tid = otid(), lane = tid & 63, wid = __builtin_amdgcn_readfirstlane(tid >> 6), dir = wid >> 2, w = wid & 3;
    const int gt = tid & 255, q = lane >> 4, L = lane & 15;
    const int b = bid & 7, head = bid >> 3, g = head / 6;
    LAS unsigned char* lds = (LAS unsigned char*)smem + dir * SSD_DIRSZ;
    const unsigned ldsa = (unsigned)(size_t)lds;
    const unsigned stB = ssd_offb(gt >> 4, gt & 15);
    const unsigned stX = ssd_offx(gt >> 3, (gt & 7) >> 1) + 16u * (gt & 1);
    unsigned rk[4], xa[4], ba[2], hw[2];
#pragma unroll
    for (int kn = 0; kn < 4; ++kn) rk[kn] = ssd_offb(L, 4 * kn + q);
#pragma unroll
    for (int pt = 0; pt < 4; ++pt) xa[pt] = ldsa + SSD_XN + ssd_offx(4 * q + (L >> 2), pt) + 8 * (L & 3);
#pragma unroll
    for (int nt = 0; nt < 2; ++nt) { ba[nt] = ldsa + SSD_BN + ssd_offb(4 * q + (L >> 2), 4 * w + 2 * nt + ((L & 3) >> 1)) + 8 * (L & 1);
                                     hw[nt] = ssd_offb(L, 4 * w + 2 * nt + (q >> 1)) + 8 * (q & 1); }
    asm volatile("" : "+v"(rk[0]), "+v"(rk[1]), "+v"(rk[2]), "+v"(rk[3]), "+v"(xa[0]), "+v"(xa[1]), "+v"(xa[2]), "+v"(xa[3]));
    asm volatile("" : "+v"(ba[0]), "+v"(ba[1]), "+v"(hw[0]), "+v"(hw[1]));
    LAS float* vec = (LAS float*)(lds + SSD_VEC);
    const int nv = dir == 0 ? w + 1 : 4 - w, jb = dir == 0 ? 0 : w;
    const unsigned jbo = 4096u * (unsigned)jb;
    const int sl = dir == 0 ? 4 * q - L : L - 4 * q;
    const float a_ = -__expf(p.a_log[dir * NHEADS + head]), dtb = p.dt_bias[dir * NHEADS + head], dsk = p.d_skip[head];
    for (int i = gt; i < 1024; i += 256) *(LAS u32x4*)(lds + SSD_HN + i * 16) = (u32x4){0u, 0u, 0u, 0u};
    f32x4 Hacc[2][4];
#pragma unroll
    for (int i = 0; i < 2; ++i)
#pragma unroll
        for (int j = 0; j < 4; ++j) Hacc[i][j] = (f32x4){0.f, 0.f, 0.f, 0.f};
    u32x4 pb[4], pc[4], px[2]; float pdt;
    bf16x8 Xf[4][2];
    int cur = 0;
    auto do_vec = [&]() -> float {
        const float v = pdt + dtb; const float ev = __expf(v); const float dtv = v > 20.f ? v : (v < -15.f ? ev : __logf(1.0f + ev));
        const float da = dtv * a_;
        float ac = da;
        ac += __int_as_float(__builtin_amdgcn_update_dpp(0, __float_as_int(ac), 0x111, 0xF, 0xF, false));
        ac += __int_as_float(__builtin_amdgcn_update_dpp(0, __float_as_int(ac), 0x112, 0xF, 0xF, false));
        ac += __int_as_float(__builtin_amdgcn_update_dpp(0, __float_as_int(ac), 0x114, 0xF, 0xF, false));
        ac += __int_as_float(__builtin_amdgcn_update_dpp(0, __float_as_int(ac), 0x118, 0xF, 0xF, false));
        ac += __int_as_float(__builtin_amdgcn_update_dpp(0, __float_as_int(ac), 0x142, 0xA, 0xF, false));
        ac += __int_as_float(__builtin_amdgcn_update_dpp(0, __float_as_int(ac), 0x143, 0xC, 0xF, false));
        const float tot = __int_as_float(__builtin_amdgcn_readlane(__float_as_int(ac), 63));
        if (dir != 0) ac = tot - ac + da;
        const float aend = tot;
        vec[lane] = ac; vec[64 + lane] = dtv; vec[128 + lane] = __expf(fminf(aend - ac, 0.f)) * dtv;
        return __expf(aend);
    };
    auto prefetch_b = [&](int ci) {
        int gl = gt; asm volatile("" : "+v"(gl));
        const bf16_t* rb = p.xbc + (size_t)(b * SEQ + ci * 64) * CONV_CH;
#pragma unroll
        for (int i = 0; i < 4; ++i) { const int q_ = gl + 256 * i, row = q_ >> 4, ch = q_ & 15; pb[i] = *(const u32x4*)(rb + (size_t)row * CONV_CH + 1536 + g * 128 + ch * 8); }
    };
    auto prefetch_c = [&](int ci) {
        int gl = gt; asm volatile("" : "+v"(gl));
        const bf16_t* rb = p.xbc + (size_t)(b * SEQ + ci * 64) * CONV_CH;
#pragma unroll
        for (int i = 0; i < 4; ++i) { const int q_ = gl + 256 * i, row = q_ >> 4, ch = q_ & 15; pc[i] = *(const u32x4*)(rb + (size_t)row * CONV_CH + 2048 + g * 128 + ch * 8); }
    };
    auto prefetch_x = [&](int ci) {
        const int r1 = b * SEQ + ci * 64;
        int gl = gt; asm volatile("" : "+v"(gl));
        const bf16_t* rb = p.xbc + (size_t)r1 * CONV_CH;
#pragma unroll
        for (int i = 0; i < 2; ++i) { const int q_ = gl + 256 * i, row = q_ >> 3, c8 = q_ & 7; px[i] = *(const u32x4*)(rb + (size_t)row * CONV_CH + head * 64 + c8 * 8); }
        pdt = p.dtraw[(size_t)(r1 + (gl & 63)) * 48 + dir * NHEADS + head];
    };
    auto prefetch = [&](int ci) { prefetch_b(ci); prefetch_c(ci); prefetch_x(ci); };
    auto load_xf = [&]() {
        s16x4 lo[8], hi[8];
        asm volatile("ds_read_b64_tr_b16 %0, %16\n\tds_read_b64_tr_b16 %8, %16 offset:2048\n\t"
                     "ds_read_b64_tr_b16 %1, %17\n\tds_read_b64_tr_b16 %9, %17 offset:2048\n\t"
                     "ds_read_b64_tr_b16 %2, %18\n\tds_read_b64_tr_b16 %10, %18 offset:2048\n\t"
                     "ds_read_b64_tr_b16 %3, %19\n\tds_read_b64_tr_b16 %11, %19 offset:2048\n\t"
                     "ds_read_b64_tr_b16 %4, %16 offset:4096\n\tds_read_b64_tr_b16 %12, %16 offset:6144\n\t"
                     "ds_read_b64_tr_b16 %5, %17 offset:4096\n\tds_read_b64_tr_b16 %13, %17 offset:6144\n\t"
                     "ds_read_b64_tr_b16 %6, %18 offset:4096\n\tds_read_b64_tr_b16 %14, %18 offset:6144\n\t"
                     "ds_read_b64_tr_b16 %7, %19 offset:4096\n\tds_read_b64_tr_b16 %15, %19 offset:6144\n\t"
                     "s_waitcnt lgkmcnt(0)"
                     : "=&v"(lo[0]), "=&v"(lo[1]), "=&v"(lo[2]), "=&v"(lo[3]), "=&v"(lo[4]), "=&v"(lo[5]), "=&v"(lo[6]), "=&v"(lo[7]),
                       "=&v"(hi[0]), "=&v"(hi[1]), "=&v"(hi[2]), "=&v"(hi[3]), "=&v"(hi[4]), "=&v"(hi[5]), "=&v"(hi[6]), "=&v"(hi[7])
                     : "v"(xa[0]), "v"(xa[1]), "v"(xa[2]), "v"(xa[3]) : "memory");
#pragma unroll
        for (int kk = 0; kk < 2; ++kk)
#pragma unroll
            for (int pt = 0; pt < 4; ++pt) Xf[pt][kk] = __builtin_shufflevector(lo[4 * kk + pt], hi[4 * kk + pt], 0, 1, 2, 3, 4, 5, 6, 7);
    };
    auto do_state = [&](float dec) {
#pragma unroll
        for (int nt = 0; nt < 2; ++nt)
#pragma unroll
            for (int pt = 0; pt < 4; ++pt) Hacc[nt][pt] *= dec;
#pragma unroll
        for (int kk = 0; kk < 2; ++kk) {
            s16x4 lo[2], hi[2];
            if (kk == 0) asm volatile("ds_read_b64_tr_b16 %0, %4\n\tds_read_b64_tr_b16 %2, %4 offset:4096\n\t"
                                      "ds_read_b64_tr_b16 %1, %5\n\tds_read_b64_tr_b16 %3, %5 offset:4096\n\t"
                                      "s_waitcnt lgkmcnt(0)"
                                      : "=&v"(lo[0]), "=&v"(lo[1]), "=&v"(hi[0]), "=&v"(hi[1]) : "v"(ba[0]), "v"(ba[1]) : "memory");
            else         asm volatile("ds_read_b64_tr_b16 %0, %4 offset:8192\n\tds_read_b64_tr_b16 %2, %4 offset:12288\n\t"
                                      "ds_read_b64_tr_b16 %1, %5 offset:8192\n\tds_read_b64_tr_b16 %3, %5 offset:12288\n\t"
                                      "s_waitcnt lgkmcnt(0)"
                                      : "=&v"(lo[0]), "=&v"(lo[1]), "=&v"(hi[0]), "=&v"(hi[1]) : "v"(ba[0]), "v"(ba[1]) : "memory");
            const f32x4 wlo = *(const LAS f32x4*)(vec + 128 + 32 * kk + 4 * q), whi = *(const LAS f32x4*)(vec + 128 + 32 * kk + 16 + 4 * q);
#pragma unroll
            for (int nt = 0; nt < 2; ++nt) {
                float m[8];
#pragma unroll
                for (int r = 0; r < 4; ++r) { m[r] = bfu(lo[nt][r]) * wlo[r]; m[4 + r] = bfu(hi[nt][r]) * whi[r]; }
                const bf16x8 Bw = ssd_pack8(m);
                __builtin_amdgcn_s_setprio(1);
#pragma unroll
                for (int pt = 0; pt < 4; ++pt) Hacc[nt][pt] = __builtin_amdgcn_mfma_f32_16x16x32_bf16(Bw, Xf[pt][kk], Hacc[nt][pt], 0, 0, 0);
                __builtin_amdgcn_s_setprio(0);
            }
        }
#pragma unroll
        for (int nt = 0; nt < 2; ++nt)
#pragma unroll
            for (int pt = 0; pt < 4; ++pt)
                *(LAS u32x2*)(lds + SSD_HN + (cur ^ 1) * 16384 + pt * 4096 + hw[nt]) = (u32x2){g8::cvt_pk_bf16(Hacc[nt][pt][0], Hacc[nt][pt][1]), g8::cvt_pk_bf16(Hacc[nt][pt][2], Hacc[nt][pt][3])};
    };
    pdt = p.dtraw[(size_t)(NLAT + b * 256 + (dir ? 3 : 0) * 64 + lane) * 48 + dir * NHEADS + head];
#pragma unroll 1
    for (int k = 0; k < 4; ++k) {
        const int cidx = dir ? 3 - k : k;
        auto convN = [&](auto nic, int rowbase, int rowstep, int ch, unsigned ldsoff) {
            constexpr int NI = decltype(nic)::value;
            u32x4 c4[NI], p4[NI], n4[NI];
#pragma unroll
            for (int i = 0; i < NI; ++i) {
                const int tg = cidx * 64 + rowbase + rowstep * i;
                const bf16_t* rp = p.xbc + (size_t)(NLAT + b * 256 + tg) * CONV_CH + ch;
                c4[i] = *(const u32x4*)rp;
                p4[i] = tg > 0 ? *(const u32x4*)(rp - CONV_CH) : (u32x4){0u, 0u, 0u, 0u};
                n4[i] = tg < 255 ? *(const u32x4*)(rp + CONV_CH) : (u32x4){0u, 0u, 0u, 0u};
            }
            f32x4 t0[2], t1[2], t2[2], t3[2];
#pragma unroll
            for (int h = 0; h < 2; ++h) { t0[h] = *(const f32x4*)(p.conv_w + ch + 4 * h); t1[h] = *(const f32x4*)(p.conv_w + CONV_CH + ch + 4 * h); t2[h] = *(const f32x4*)(p.conv_w + 2 * CONV_CH + ch + 4 * h); t3[h] = *(const f32x4*)(p.conv_b + ch + 4 * h); }
#pragma unroll
            for (int i = 0; i < NI; ++i) {
                float c_[8], p_[8], n_[8], o_[8];
                unpack8(c4[i], c_); unpack8(p4[i], p_); unpack8(n4[i], n_);
#pragma unroll
                for (int h = 0; h < 2; ++h)
#pragma unroll
                    for (int j = 0; j < 4; ++j) o_[4 * h + j] = siluf(t0[h][j] * p_[4 * h + j] + t1[h][j] * c_[4 * h + j] + t2[h][j] * n_[4 * h + j] + t3[h][j]);
                *(LAS u32x4*)(lds + ldsoff + 4096 * i) = (u32x4){g8::cvt_pk_bf16(o_[0], o_[1]), g8::cvt_pk_bf16(o_[2], o_[3]), g8::cvt_pk_bf16(o_[4], o_[5]), g8::cvt_pk_bf16(o_[6], o_[7])};
            }
        };
        convN(IC<4>{}, gt >> 4, 16, 1536 + g * 128 + (gt & 15) * 8, SSD_BN + stB);
        convN(IC<2>{}, gt >> 3, 32, head * 64 + (gt & 7) * 8, SSD_XN + stX);
        const float dec = do_vec();
        __syncthreads();
        if (k < 3) pdt = p.dtraw[(size_t)(NLAT + b * 256 + (dir ? 2 - k : k + 1) * 64 + lane) * 48 + dir * NHEADS + head];
        else prefetch(dir ? 63 : 0);
        load_xf();
        do_state(dec);
        __syncthreads();
        cur ^= 1;
    }
#pragma unroll 1
    for (int k = 4; k < 68; ++k) {
        const int cidx = dir ? 67 - k : k - 4;
        const int r0 = b * SEQ + cidx * 64;
#pragma unroll
        for (int i = 0; i < 4; ++i) { *(LAS u32x4*)(lds + SSD_BN + 4096 * i + stB) = pb[i]; *(LAS u32x4*)(lds + SSD_CN + 4096 * i + stB) = pc[i]; }
#pragma unroll
        for (int i = 0; i < 2; ++i) *(LAS u32x4*)(lds + SSD_XN + 4096 * i + stX) = px[i];
        if (((k + 2 * dir) & 3) == w) { const float d_ = do_vec(); if (lane == 0) vec[192] = d_; }
        if (k == 36) asm volatile("s_waitcnt vmcnt(0)" ::: "memory");
        __syncthreads();
        const float dec = vec[192];
        const int cnext = dir ? (66 - k > 0 ? 66 - k : 0) : (k - 3 < 63 ? k - 3 : 63);
        const int t = 16 * w + L;
        const bool second = dir == 0 ? (cidx >= 32) : (cidx <= 31);
        bf16_t* yrow = p.av + (size_t)(r0 + t) * AVLD + 1024 + head * 64 + 4 * q;
        u32x2 yold[4], zz[4];
        if (second) {
            const bf16_t* zrow = p.z + (size_t)(r0 + t) * D_INNER + head * 64 + 4 * q;
#pragma unroll
            for (int pt = 0; pt < 4; ++pt) { yold[pt] = *(const u32x2*)(yrow + 16 * pt); zz[pt] = *(const u32x2*)(zrow + 16 * pt); }
        }
        __builtin_amdgcn_sched_barrier(0);
        prefetch_b(cnext);
        __builtin_amdgcn_sched_barrier(0);
        load_xf();
        __builtin_amdgcn_sched_barrier(0);
        prefetch_c(cnext);
        __builtin_amdgcn_sched_barrier(0);
        {
            const float acum_t = vec[t], ea = __expf(acum_t);
            bf16x8 Cf[4];
#pragma unroll
            for (int kn = 0; kn < 4; ++kn) Cf[kn] = *(const LAS bf16x8*)(lds + SSD_CN + w * 4096 + rk[kn]);
            bf16x8 Mf[2];
            auto cbm = [&](auto nvc) {
                constexpr int NV = decltype(nvc)::value;
                f32x4 cb[NV]; bf16x8 Bq[2][NV];
#pragma unroll
                for (int i = 0; i < NV; ++i) Bq[0][i] = *(const LAS bf16x8*)(lds + SSD_BN + i * 4096 + jbo + rk[0]);
#pragma unroll
                for (int kn = 0; kn < 4; ++kn) {
                    if (kn < 3) {
#pragma unroll
                        for (int i = 0; i < NV; ++i) Bq[(kn + 1) & 1][i] = *(const LAS bf16x8*)(lds + SSD_BN + i * 4096 + jbo + rk[kn + 1]);
                    }
                    __builtin_amdgcn_sched_barrier(0);
                    __builtin_amdgcn_s_setprio(1);
#pragma unroll
                    for (int i = 0; i < NV; ++i) cb[i] = __builtin_amdgcn_mfma_f32_16x16x32_bf16(Bq[kn & 1][i], Cf[kn], kn == 0 ? (f32x4){0.f, 0.f, 0.f, 0.f} : cb[i], 0, 0, 0);
                    __builtin_amdgcn_s_setprio(0);
                }
                f32x4 as_[NV], ds_[NV];
#pragma unroll
                for (int i = 0; i < NV; ++i) { as_[i] = *(const LAS f32x4*)(vec + 16 * jb + 16 * i + 4 * q); ds_[i] = *(const LAS f32x4*)(vec + 64 + 16 * jb + 16 * i + 4 * q); }
                unsigned pk[NV][2];
#pragma unroll
                for (int i = 0; i < NV; ++i) {
                    float m[4];
#pragma unroll
                    for (int r = 0; r < 4; ++r) {
                        const float e = __expf(fminf(acum_t - as_[i][r], 0.f));
                        float v = cb[i][r] * e * ds_[i][r];
                        if (i == 0 || i == NV - 1) {
                            const bool diag = dir ? (i == 0) : (i == NV - 1);
                            if (diag && sl > (dir ? r : -r)) v = 0.f;
                        }
                        m[r] = v;
                    }
                    pk[i][0] = g8::cvt_pk_bf16(m[0], m[1]); pk[i][1] = g8::cvt_pk_bf16(m[2], m[3]);
                }
                unsigned d[4][2];
#pragma unroll
                for (int j = 0; j < 4; ++j)
#pragma unroll
                    for (int h = 0; h < 2; ++h) {
                        const unsigned f = j < NV ? pk[j < NV ? j : 0][h] : 0u;
                        const unsigned bw = j >= 4 - NV ? pk[j >= 4 - NV ? j - (4 - NV) : 0][h] : 0u;
                        d[j][h] = NV == 4 ? f : (dir ? bw : f);
                    }
                union { u32x4 u; bf16x8 b; } c0, c1; c0.u = (u32x4){d[0][0], d[0][1], d[1][0], d[1][1]}; c1.u = (u32x4){d[2][0], d[2][1], d[3][0], d[3][1]};
                Mf[0] = c0.b; Mf[1] = c1.b;
            };
            if (nv == 4) cbm(IC<4>{}); else if (nv == 3) cbm(IC<3>{}); else if (nv == 2) cbm(IC<2>{}); else cbm(IC<1>{});
            __builtin_amdgcn_sched_barrier(0);
            prefetch_x(cnext);
            __builtin_amdgcn_sched_barrier(0);
            f32x4 yT[4];
            bf16x8 Hf[2][4];
#pragma unroll
            for (int kn = 0; kn < 4; ++kn) Hf[0][kn] = *(const LAS bf16x8*)(lds + SSD_HN + cur * 16384 + rk[kn]);
#pragma unroll
            for (int pt = 0; pt < 4; ++pt) {
                yT[pt] = (f32x4){0.f, 0.f, 0.f, 0.f};
                if (pt < 3) {
#pragma unroll
                    for (int kn = 0; kn < 4; ++kn) Hf[(pt + 1) & 1][kn] = *(const LAS bf16x8*)(lds + SSD_HN + cur * 16384 + (pt + 1) * 4096 + rk[kn]);
                }
                __builtin_amdgcn_sched_barrier(0);
                __builtin_amdgcn_s_setprio(1);
#pragma unroll
                for (int kn = 0; kn < 4; ++kn) yT[pt] = __builtin_amdgcn_mfma_f32_16x16x32_bf16(Hf[pt & 1][kn], Cf[kn], yT[pt], 0, 0, 0);
                yT[pt] *= ea;
#pragma unroll
                for (int kk = 0; kk < 2; ++kk) yT[pt] = __builtin_amdgcn_mfma_f32_16x16x32_bf16(Xf[pt][kk], Mf[kk], yT[pt], 0, 0, 0);
                __builtin_amdgcn_s_setprio(0);
            }
            do_state(dec);
            float ssq_acc = 0.f;
#pragma unroll
            for (int pt = 0; pt < 4; ++pt) {
                float o[4] = {yT[pt][0], yT[pt][1], yT[pt][2], yT[pt][3]};
                if (dir == 0) { const u32x2 xx = *(const LAS u32x2*)(lds + SSD_XN + ssd_offx(t, pt) + 8 * q);
                    o[0] += dsk * __uint_as_float(xx[0] << 16); o[1] += dsk * __uint_as_float(xx[0] & 0xffff0000u); o[2] += dsk * __uint_as_float(xx[1] << 16); o[3] += dsk * __uint_as_float(xx[1] & 0xffff0000u); }
                if (second) { const u32x2 yo = yold[pt], zv = zz[pt];
                    o[0] += __uint_as_float(yo[0] << 16); o[1] += __uint_as_float(yo[0] & 0xffff0000u); o[2] += __uint_as_float(yo[1] << 16); o[3] += __uint_as_float(yo[1] & 0xffff0000u);
                    o[0] *= __uint_as_float(zv[0] << 16); o[1] *= __uint_as_float(zv[0] & 0xffff0000u); o[2] *= __uint_as_float(zv[1] << 16); o[3] *= __uint_as_float(zv[1] & 0xffff0000u);
                    ssq_acc += (o[0] * o[0] + o[1] * o[1]) + (o[2] * o[2] + o[3] * o[3]); }
                *(u32x2*)(yrow + 16 * pt) = (u32x2){g8::cvt_pk_bf16(o[0], o[1]), g8::cvt_pk_bf16(o[2], o[3])};
            }
            if (second) { ssq_acc += __shfl_xor(ssq_acc, 16); ssq_acc += __shfl_xor(ssq_acc, 32); if (q == 0) p.ssq[(size_t)(r0 + t) * NHEADS + head] = ssq_acc; }
        }
        __syncthreads();
        cur ^= 1;
    }
}

__device__ __forceinline__ void phase_post1(const Params& p, int bid, int nblk, char* smem) {
    const int TIDX = otid();
    float* srow = (float*)smem;
    float* part = srow + 16 * 1028;
    const int lane = TIDX & 63, wv = TIDX >> 6, e = lane & 15, ks = lane >> 4;
    bf16x8 Whi[4], Wlo[4];
    { const float* wr_ = p.w_router + (size_t)(128 * wv + 8 * ks) * 16 + e;
#pragma unroll
      for (int t = 0; t < 4; ++t) {
          float wv_[8], lo_[8]; unsigned hu[4];
#pragma unroll
          for (int i = 0; i < 8; ++i) wv_[i] = wr_[(32 * t + i) * 16];
#pragma unroll
          for (int i = 0; i < 4; ++i) { hu[i] = g8::cvt_pk_bf16(wv_[2 * i], wv_[2 * i + 1]); lo_[2 * i] = wv_[2 * i] - __uint_as_float(hu[i] << 16); lo_[2 * i + 1] = wv_[2 * i + 1] - __uint_as_float(hu[i] & 0xffff0000u); }
          union { u32x4 u; bf16x8 b; } ch, cl; ch.u = (u32x4){hu[0], hu[1], hu[2], hu[3]};
          cl.u = (u32x4){g8::cvt_pk_bf16(lo_[0], lo_[1]), g8::cvt_pk_bf16(lo_[2], lo_[3]), g8::cvt_pk_bf16(lo_[4], lo_[5]), g8::cvt_pk_bf16(lo_[6], lo_[7])};
          Whi[t] = ch.b; Wlo[t] = cl.b; } }
    const int rpb = NLAT / nblk, npass = rpb / 16, rbase = bid * rpb;
    f32x4 A1[4], A2[4], A3[4];
    { const float* mv = p.mod + (rbase / SEQ) * 6144;
#pragma unroll
      for (int i = 0; i < 4; ++i) { const int k = i * 256 + lane * 4;
          A1[i] = *(const f32x4*)(mv + 2048 + k) * *(const f32x4*)(p.norm_mix_post + k);
          A2[i] = *(const f32x4*)(p.norm_ffn_pre + k) * (*(const f32x4*)(mv + 4096 + k) + 1.0f);
          A3[i] = *(const f32x4*)(mv + 3072 + k); } }
    uint2 mu[2][4], mun[2][4]; f32x4 xall[2][4], xn[2][4];
    auto loadrows = [&](int r0, uint2 (&m_)[2][4], f32x4 (&x_)[2][4]) {
#pragma unroll
        for (int rr = 0; rr < 2; ++rr)
#pragma unroll
            for (int i = 0; i < 4; ++i) { const size_t o = (size_t)(r0 + wv * 2 + rr) * 1024 + i * 256 + lane * 4; x_[rr][i] = __builtin_nontemporal_load((const f32x4*)(p.x + o)); m_[rr][i] = *(const uint2*)(p.mix + o); }
    };
    loadrows(rbase, mu, xall);
#pragma unroll 1
    for (int it = 0; it < npass; ++it) {
        const int r0 = rbase + it * 16;
        loadrows(it + 1 < npass ? r0 + 16 : r0, mun, xn);
#pragma unroll
        for (int rr = 0; rr < 2; ++rr) {
            const int rl = wv * 2 + rr, row = r0 + rl;
            float mx[16]; float ss = 0.f;
#pragma unroll
            for (int i = 0; i < 4; ++i) {
                const uint2 u = mu[rr][i];
                mx[i * 4 + 0] = __uint_as_float(u.x << 16); mx[i * 4 + 1] = __uint_as_float(u.x & 0xffff0000u);
                mx[i * 4 + 2] = __uint_as_float(u.y << 16); mx[i * 4 + 3] = __uint_as_float(u.y & 0xffff0000u);
            }
#pragma unroll
            for (int i = 0; i < 16; ++i) ss += mx[i] * mx[i];
            ss = wave_sum(ss);
            const float rstd = rsqrtf(ss * (1.0f / 1024.0f) + RMS_EPS);
            float hx[16]; float ss2 = 0.f;
#pragma unroll
            for (int i = 0; i < 4; ++i) {
                const int k = i * 256 + lane * 4;
#pragma unroll
                for (int j = 0; j < 4; ++j) { const float v = xall[rr][i][j] + A1[i][j] * (mx[i * 4 + j] * rstd); hx[i * 4 + j] = v; ss2 += v * v; }
                *(uint2*)(p.hx1 + (size_t)row * 1024 + k) = make_uint2(g8::cvt_pk_bf16(hx[i * 4], hx[i * 4 + 1]), g8::cvt_pk_bf16(hx[i * 4 + 2], hx[i * 4 + 3]));
            }
            ss2 = wave_sum(ss2);
            const float rstd2 = rsqrtf(ss2 * (1.0f / 1024.0f) + RMS_EPS);
#pragma unroll
            for (int i = 0; i < 4; ++i) {
                const int k = i * 256 + lane * 4;
                f32x4 vv;
#pragma unroll
                for (int j = 0; j < 4; ++j) vv[j] = hx[i * 4 + j] * rstd2 * A2[i][j] + A3[i][j];
                *(f32x4*)(srow + rl * 1028 + k) = vv;
                { int pk = __builtin_amdgcn_cvt_pk_fp8_f32(clamp8(vv[0]), clamp8(vv[1]), 0, false); pk = __builtin_amdgcn_cvt_pk_fp8_f32(clamp8(vv[2]), clamp8(vv[3]), pk, true); *(int*)(p.h2q + (size_t)row * 1024 + k) = pk; }
            }
            asm volatile("" ::: "memory");
        }
        __syncthreads();
        {
            f32x4 racc = (f32x4){0.f, 0.f, 0.f, 0.f};
#pragma unroll
            for (int t = 0; t < 4; ++t) {
                const float* ap = srow + e * 1028 + 128 * wv + 32 * t + 8 * ks;
                const f32x4 a0 = *(const f32x4*)ap, a1 = *(const f32x4*)(ap + 4);
                const float a[8] = {a0[0], a0[1], a0[2], a0[3], a1[0], a1[1], a1[2], a1[3]};
                float lo_[8]; unsigned hu[4];
#pragma unroll
                for (int i = 0; i < 4; ++i) { hu[i] = g8::cvt_pk_bf16(a[2 * i], a[2 * i + 1]); lo_[2 * i] = a[2 * i] - __uint_as_float(hu[i] << 16); lo_[2 * i + 1] = a[2 * i + 1] - __uint_as_float(hu[i] & 0xffff0000u); }
                union { u32x4 u; bf16x8 b; } ch, cl; ch.u = (u32x4){hu[0], hu[1], hu[2], hu[3]};
                cl.u = (u32x4){g8::cvt_pk_bf16(lo_[0], lo_[1]), g8::cvt_pk_bf16(lo_[2], lo_[3]), g8::cvt_pk_bf16(lo_[4], lo_[5]), g8::cvt_pk_bf16(lo_[6], lo_[7])};
                racc = __builtin_amdgcn_mfma_f32_16x16x32_bf16(cl.b, Whi[t], racc, 0, 0, 0);
                racc = __builtin_amdgcn_mfma_f32_16x16x32_bf16(ch.b, Wlo[t], racc, 0, 0, 0);
                racc = __builtin_amdgcn_mfma_f32_16x16x32_bf16(ch.b, Whi[t], racc, 0, 0, 0);
            }
#pragma unroll
            for (int j = 0; j < 4; ++j) part[((4 * ks + j) * 8 + wv) * 16 + e] = racc[j];
        }
        __syncthreads();
        if (TIDX < 256) {
            const int r = TIDX >> 4;
            float lg = 0.f;
#pragma unroll
            for (int w8 = 0; w8 < 8; ++w8) lg += part[(r * 8 + w8) * 16 + e];
            float mxl = lg;
#pragma unroll
            for (int o = 8; o >= 1; o >>= 1) mxl = fmaxf(mxl, __shfl_xor(mxl, o));
            const float ex = __expf(lg - mxl);
            float se = ex;
#pragma unroll
            for (int o = 8; o >= 1; o >>= 1) se += __shfl_xor(se, o);
            p.aff[(size_t)(r0 + r) * 16 + e] = ex * frcp(se);
        }
#pragma unroll
        for (int rr = 0; rr < 2; ++rr)
#pragma unroll
            for (int i = 0; i < 4; ++i) { mu[rr][i] = mun[rr][i]; xall[rr][i] = xn[rr][i]; }
    }
}

__device__ __forceinline__ void phase_topk(const Params& p, int bid, int nblk, char* smem) {
    const int TIDX = otid();
    unsigned* keys = (unsigned*)smem;
    unsigned* hist = keys + 4096;
    unsigned* scanbuf = hist + 256;
    unsigned* sh = scanbuf + 512;
    const int tid = TIDX;
    for (int be = bid; be < BATCH * N_EXP; be += nblk) {
        const int b = be >> 4, e = be & 15;
        __syncthreads();
        for (int i = tid; i < 4096; i += NT) keys[i] = __float_as_uint(p.aff[(size_t)(b * SEQ + i) * 16 + e]);
        unsigned prefix = 0, mask = 0, need = CAP;
        for (int pass = 0; pass < 4; ++pass) {
            const int shift = 24 - 8 * pass;
            if (tid < 256) hist[tid] = 0;
            __syncthreads();
            for (int i = tid; i < 4096; i += NT) { const unsigned k = keys[i]; if ((k & mask) == prefix) atomicAdd(&hist[(k >> shift) & 255u], 1u); }
            __syncthreads();
            if (tid < 64) {
                const unsigned c0 = hist[4 * tid], c1 = hist[4 * tid + 1], c2 = hist[4 * tid + 2], c3 = hist[4 * tid + 3];
                unsigned S = c0 + c1 + c2 + c3;
#pragma unroll
                for (int o = 1; o < 64; o <<= 1) { const unsigned t = __shfl_down(S, o); if (tid + o < 64) S += t; }
                const unsigned long long m = __ballot(S >= need);
                const int Lsel = 63 - __builtin_clzll(m);
                unsigned above = __shfl_down(S, 1); if (tid == 63) above = 0;
                if (tid == Lsel) {
                    unsigned cum = above; int sel;
                    if (cum + c3 >= need) sel = 3; else { cum += c3; if (cum + c2 >= need) sel = 2; else { cum += c2; if (cum + c1 >= need) sel = 1; else { cum += c1; sel = 0; } } }
                    sh[0] = prefix | ((unsigned)(4 * tid + sel) << shift); sh[1] = need - cum;
                }
            }
            __syncthreads();
            prefix = sh[0]; need = sh[1]; mask |= 255u << shift;
            __syncthreads();
        }
        const unsigned T = prefix;
        unsigned cgt = 0, ceq = 0;
        for (int i = 0; i < 8; ++i) { const unsigned k = keys[tid * 8 + i]; cgt += (k > T); ceq += (k == T); }
        unsigned incl = cgt | (ceq << 16);
        { const int ln = tid & 63;
#pragma unroll
          for (int o = 1; o < 64; o <<= 1) { const unsigned t = __shfl_up(incl, o); if (ln >= o) incl += t; }
          if (ln == 63) scanbuf[tid >> 6] = incl; }
        __syncthreads();
        unsigned woff = 0;
        for (int w = 0; w < (tid >> 6); ++w) woff += scanbuf[w];
        const unsigned excl = woff + incl - (cgt | (ceq << 16));
        unsigned posg = excl & 0xffffu, pose = excl >> 16;
        const unsigned ngreater = CAP - need;
        for (int i = 0; i < 8; ++i) {
            const int tok = tid * 8 + i; const unsigned k = keys[tok];
            int slot = -1;
            if (k > T) slot = (int)(posg++);
            else if (k == T) { if (pose < need) slot = (int)(ngreater + pose); pose++; }
            p.slot_of[(size_t)(b * SEQ + tok) * 16 + e] = slot;
            if (slot >= 0) { p.topidx[be * CAP + slot] = tok; p.topaff[be * CAP + slot] = __uint_as_float(k); }
        }
    }
}

__device__ __forceinline__ void phase_final(const Params& p, int bid, int nblk) {
    const int TIDX = otid();
    const int lane = TIDX & 63, wv = TIDX >> 6;
    const int rpb = NLAT / nblk;
    const int b = (bid * rpb) / SEQ; const float* mv = p.mod + b * 6144;
    f32x4 A4[4];
#pragma unroll
    for (int i = 0; i < 4; ++i) { const int k = i * 256 + lane * 4; A4[i] = *(const f32x4*)(mv + 5120 + k) * *(const f32x4*)(p.norm_ffn_post + k); }
    int row2 = bid * rpb + wv * 2;
    int myslot = lane < 32 ? p.slot_of[(size_t)row2 * 16 + lane] : -1;
    uint2 hu[2][4];
#pragma unroll
    for (int r = 0; r < 2; ++r)
#pragma unroll
        for (int i = 0; i < 4; ++i) hu[r][i] = *(const uint2*)(p.hx1 + (size_t)(row2 + r) * 1024 + i * 256 + lane * 4);
    const int npass = rpb / 16;
#pragma unroll 1
    for (int it = 0; it < npass; ++it, row2 += 16) {
        const unsigned long long mall = __ballot(myslot >= 0);
        unsigned u0[2][4], u1[2][4]; float f0[2], f1[2]; unsigned long long mrest[2];
#pragma unroll
        for (int r = 0; r < 2; ++r) {
            unsigned long long m = (mall >> (16 * r)) & 0xffffull;
            const bool has = m != 0; const int e0 = has ? __builtin_ctzll(m) : 0; if (has) m &= m - 1;
            const bool two = m != 0; const int e1 = two ? __builtin_ctzll(m) : e0; if (two) m &= m - 1;
            int s0 = __shfl(myslot, 16 * r + e0), s1 = __shfl(myslot, 16 * r + e1); if (!has) { s0 = 0; s1 = 0; }
            const unsigned char* src0 = p.ye8 + ((size_t)(b * 16 + e0) * CAP + s0) * 1024 + lane * 4;
            const unsigned char* src1 = p.ye8 + ((size_t)(b * 16 + e1) * CAP + s1) * 1024 + lane * 4;
#pragma unroll
            for (int i = 0; i < 4; ++i) { u0[r][i] = *(const unsigned*)(src0 + i * 256); u1[r][i] = *(const unsigned*)(src1 + i * 256); }
            f0[r] = has ? 0.015625f : 0.f; f1[r] = two ? 0.015625f : 0.f; mrest[r] = m;
        }
        int myslot_n = -1; uint2 hn[2][4];
        { const int rn = it + 1 < npass ? row2 + 16 : row2;
          if (lane < 32) myslot_n = p.slot_of[(size_t)rn * 16 + lane];
#pragma unroll
          for (int r = 0; r < 2; ++r)
#pragma unroll
              for (int i = 0; i < 4; ++i) hn[r][i] = *(const uint2*)(p.hx1 + (size_t)(rn + r) * 1024 + i * 256 + lane * 4); }
#pragma unroll
        for (int r = 0; r < 2; ++r) {
            float acc[16];
#pragma unroll
            for (int i = 0; i < 4; ++i) {
                acc[i * 4 + 0] = f0[r] * __builtin_amdgcn_cvt_f32_fp8((int)u0[r][i], 0) + f1[r] * __builtin_amdgcn_cvt_f32_fp8((int)u1[r][i], 0); acc[i * 4 + 1] = f0[r] * __builtin_amdgcn_cvt_f32_fp8((int)u0[r][i], 1) + f1[r] * __builtin_amdgcn_cvt_f32_fp8((int)u1[r][i], 1);
                acc[i * 4 + 2] = f0[r] * __builtin_amdgcn_cvt_f32_fp8((int)u0[r][i], 2) + f1[r] * __builtin_amdgcn_cvt_f32_fp8((int)u1[r][i], 2); acc[i * 4 + 3] = f0[r] * __builtin_amdgcn_cvt_f32_fp8((int)u0[r][i], 3) + f1[r] * __builtin_amdgcn_cvt_f32_fp8((int)u1[r][i], 3);
            }
            unsigned long long m = mrest[r];
            while (m) {
                const int e0 = __builtin_ctzll(m); m &= m - 1;
                const bool two = m != 0; const int e1 = two ? __builtin_ctzll(m) : e0; if (two) m &= m - 1;
                const int s0 = __shfl(myslot, 16 * r + e0), s1 = __shfl(myslot, 16 * r + e1);
                const unsigned char* src0 = p.ye8 + ((size_t)(b * 16 + e0) * CAP + s0) * 1024 + lane * 4;
                const unsigned char* src1 = p.ye8 + ((size_t)(b * 16 + e1) * CAP + s1) * 1024 + lane * 4;
                unsigned v0[4], v1[4];
#pragma unroll
                for (int i = 0; i < 4; ++i) { v0[i] = *(const unsigned*)(src0 + i * 256); v1[i] = *(const unsigned*)(src1 + i * 256); }
                const float g0_ = 0.015625f, g1_ = two ? 0.015625f : 0.f;
#pragma unroll
                for (int i = 0; i < 4; ++i) {
                    acc[i * 4 + 0] += g0_ * __builtin_amdgcn_cvt_f32_fp8((int)v0[i], 0) + g1_ * __builtin_amdgcn_cvt_f32_fp8((int)v1[i], 0); acc[i * 4 + 1] += g0_ * __builtin_amdgcn_cvt_f32_fp8((int)v0[i], 1) + g1_ * __builtin_amdgcn_cvt_f32_fp8((int)v1[i], 1);
                    acc[i * 4 + 2] += g0_ * __builtin_amdgcn_cvt_f32_fp8((int)v0[i], 2) + g1_ * __builtin_amdgcn_cvt_f32_fp8((int)v1[i], 2); acc[i * 4 + 3] += g0_ * __builtin_amdgcn_cvt_f32_fp8((int)v0[i], 3) + g1_ * __builtin_amdgcn_cvt_f32_fp8((int)v1[i], 3);
                }
            }
            float ss = 0.f;
#pragma unroll
            for (int i = 0; i < 16; ++i) ss += acc[i] * acc[i];
            ss = wave_sum(ss);
            const float rstd = rsqrtf(ss * (1.0f / 1024.0f) + RMS_EPS);
#pragma unroll
            for (int i = 0; i < 4; ++i) {
                const int k = i * 256 + lane * 4;
                const uint2 u = hu[r][i];
                float4 o = make_float4(__uint_as_float(u.x << 16), __uint_as_float(u.x & 0xffff0000u), __uint_as_float(u.y << 16), __uint_as_float(u.y & 0xffff0000u));
                o.x += A4[i][0] * (acc[i * 4 + 0] * rstd); o.y += A4[i][1] * (acc[i * 4 + 1] * rstd);
                o.z += A4[i][2] * (acc[i * 4 + 2] * rstd); o.w += A4[i][3] * (acc[i * 4 + 3] * rstd);
                *(float4*)(p.out + (size_t)(row2 + r) * 1024 + k) = o;
            }
        }
        myslot = myslot_n;
#pragma unroll
        for (int r = 0; r < 2; ++r)
#pragma unroll
            for (int i = 0; i < 4; ++i) hu[r][i] = hn[r][i];
    }
}

struct KArgs { const float* in[25]; float* out; char* ws; unsigned* bar; };
__device__ __host__ __forceinline__ Params expand(const KArgs& k) {
    Params p{};
    p.x = k.in[0]; p.c = k.in[1]; p.ctx = k.in[2]; p.c_ctx = k.in[3]; p.w_mod = k.in[4]; p.b_mod = k.in[5]; p.norm_mix_pre = k.in[6]; p.norm_mix_post = k.in[7];
    p.norm_ffn_pre = k.in[8]; p.norm_ffn_post = k.in[9]; p.w_in = k.in[10]; p.conv_w = k.in[11]; p.conv_b = k.in[12]; p.dt_bias = k.in[13]; p.a_log = k.in[14]; p.d_skip = k.in[15];
    p.ssd_norm = k.in[16]; p.w_fourier = k.in[17]; p.w_ssd_out = k.in[18]; p.b_gate = k.in[19]; p.w_out = k.in[20]; p.w_router = k.in[21]; p.w_e_gate = k.in[22]; p.w_e_up = k.in[23]; p.w_e_down = k.in[24];
    p.out = k.out;
    char* ws = k.ws; const size_t MiB = 1u << 20;
    p.xbc = (bf16_t*)(ws + 0 * MiB);
    p.mix = (bf16_t*)(ws + 0 * MiB);
    p.hid = (bf16_t*)(ws + 0 * MiB);
    p.z = (bf16_t*)(ws + 170 * MiB);
    p.h2 = (bf16_t*)(ws + 170 * MiB);
    p.WdT = (bf16_t*)(ws + 234 * MiB);
    p.av = (bf16_t*)(ws + 266 * MiB);
    p.h = (bf16_t*)(ws + 266 * MiB);
    p.uf = (bf16_t*)(ws + 334 * MiB);
    p.WinT = (bf16_t*)(ws + 366 * MiB);
    p.WguT = (bf16_t*)(ws + 266 * MiB);
    p.ye = (bf16_t*)(ws + 266 * MiB);
    p.ye8 = (unsigned char*)(ws + 266 * MiB);
    p.ufT = (bf16_t*)(ws + 426 * MiB);
    p.dmat = (signed char*)(ws + 458 * MiB);
    p.ueT = (signed char*)((char*)k.out + 64 * MiB);
    p.uoT = (signed char*)((char*)k.out + 80 * MiB);
    p.use = (float*)(ws + 510 * MiB + 294912);
    p.uso = (float*)(ws + 510 * MiB + 311296);
    p.umid = (float*)(ws + 510 * MiB + 262144);
    p.ualt = (float*)(ws + 510 * MiB + 278528);
    p.merged = (bf16_t*)(ws + 64 * MiB);
    p.merged8 = (unsigned char*)(ws + 64 * MiB);
    p.WmT = (bf16_t*)(ws + 490 * MiB);
    p.WoT = (bf16_t*)(ws + 495 * MiB);
    p.WoT8 = (unsigned char*)(ws + 495 * MiB);
    p.dtraw = (float*)(ws + 497 * MiB);
    p.mod = (float*)(ws + 504 * MiB);
    p.pmod = (float*)(ws + 511 * MiB);
    p.aff = (float*)(ws + 505 * MiB);
    p.slot_of = (int*)(ws + 507 * MiB);
    p.ssq = (float*)(ws + 505 * MiB);
    p.h2q = (unsigned char*)(ws + 170 * MiB);
    p.hx1 = (bf16_t*)(ws + 394 * MiB);
    p.hq = (signed char*)(ws + 266 * MiB);
    p.WinQ = (signed char*)(ws + 366 * MiB);
    p.colmax = (unsigned*)(ws + 510 * MiB + 16384);
    p.wscale = (float*)(ws + 510 * MiB + 49152);
    p.hscale = (float*)(ws + 510 * MiB + 98304);
    p.WdT8 = (unsigned char*)(ws + 474 * MiB);
    p.WguT8 = (unsigned char*)((char*)k.out + 96 * MiB);
    p.hid8 = (unsigned char*)(ws + 0 * MiB);
    p.topidx = (int*)(ws + 509 * MiB);
    p.topaff = (float*)(ws + 509 * MiB + 512 * 1024);
    p.gq = (unsigned char*)k.out;
    return p;
}
__global__ void __launch_bounds__(NT) mega(KArgs ka) {
    const Params p = expand(ka);
    extern __shared__ __attribute__((aligned(16))) char smem[];
    cg::grid_group grid = cg::this_grid();
    const int bid = blockIdx.x, nblk = gridDim.x;
    LAS unsigned char* lds = (LAS unsigned char*)smem;
    volatile LAS unsigned* xst = (volatile LAS unsigned*)(lds + XB_LDS_OFF);
    if (threadIdx.x < 4) xst[threadIdx.x] = 0u;
    __syncthreads();
    const XcdBarrier xbar = xcd_barrier_post(ka.bar, xst);
    if (ka.ws == nullptr) grid.sync();
    if (bid < 192) phase_mod(p, bid, nblk, smem);
    else phase_dmat(p, bid - 192, nblk - 192);
    asm volatile("s_waitcnt vmcnt(0)" ::: "memory");
    __syncthreads();
    if (threadIdx.x == 0) { __builtin_amdgcn_fence(__ATOMIC_RELEASE, "agent"); (void)xb_add(&ka.bar[XB_MODCNT], 1u); }
    phase_winq(p, bid, nblk, smem);
    if (threadIdx.x == 0) { XB_SPIN(xb_ld(&ka.bar[XB_MODCNT]) < (unsigned)nblk, ka.bar); __builtin_amdgcn_fence(__ATOMIC_ACQUIRE, "agent"); asm volatile("s_waitcnt vmcnt(0)" ::: "memory"); }
    __syncthreads();
    phase_modsum(p, bid, nblk);
    phase_modulate(p, bid, nblk, smem);
    xcd_barrier(xbar);
    { const int tq = otid();
      for (int i = tq; i < CONV_CH; i += NT) *(LAS u32x2*)(lds + CONVT_OFF + i * 8) = (u32x2){g8::cvt_pk_bf16(p.conv_w[i], p.conv_w[CONV_CH + i]), g8::cvt_pk_bf16(p.conv_w[2 * CONV_CH + i], p.conv_b[i])};
      __syncthreads(); }
    { SchedInProj S{(const char*)p.hq, (const char*)p.WinQ, nblk, bid}; EpiInProj E{p, lds}; g8::gemm8<EpiInProj, SchedInProj, false, false, true>(lds, 1024u, 1024u, S, E); }
    xcd_barrier(xbar);
    if (bid >= 192) { dft_evenodd(p, bid - 192); SchedDft S{(const char*)p.dmat, (const char*)p.ueT, (const char*)p.uoT, bid - 192}; EpiDft E{p}; g8::gemm8<EpiDft, SchedDft, false, false, true>(lds, 2048u, 2048u, S, E);
                      phase_prep2(p, bid - 192, nblk - 192, 0, PREP2_SPLIT, smem);
                      { GenPrepO8 g{p, bid - 192, nblk - 192}; tr_stream8(g, smem); }
                      phase_prep(p, bid - 192, nblk - 192, smem); }
    phase_ssd(p, bid, nblk, smem);
    xcd_barrier(xbar);
    merged_prologue(p, bid, nblk, lds);
    { SchedMerged S{(const char*)p.av, (const char*)p.WmT, nblk, bid}; EpiMerged E{p, lds}; g8::gemm8<EpiMerged, SchedMerged, false, false, false, true>(lds, AVLD * 2u, AVLD * 2u, S, E); }
    xcd_barrier(xbar);
    { SchedWOut S{(const char*)p.merged8, (const char*)p.WoT8, nblk, bid}; EpiWOut E{p}; g8::gemm8<EpiWOut, SchedWOut, false, true>(lds, 1024u, 1024u, S, E); }
    xcd_barrier(xbar);
    phase_post1(p, bid, nblk, smem);
    xcd_barrier(xbar);
    if (bid >= 128) phase_prep2(p, bid - 128, nblk - 128, PREP2_SPLIT, PREP2_SPLIT + 1792, smem);
    else { phase_topk(p, bid, nblk, smem); phase_prep2(p, bid, 128, PREP2_SPLIT + 1792, 6144, smem); }
    xcd_barrier(xbar);
    { SchedExpUp S{(const char*)p.h2q, (const char*)p.WguT8, p.topidx, nblk, bid}; EpiExpUp E{p}; g8::gemm8<EpiExpUp, SchedExpUp, true, true>(lds, 1024u, 1024u, S, E); }
    xcd_barrier(xbar);
    { SchedExpDown S{(const char*)p.hid8, (const char*)p.WdT8, nblk, bid}; EpiExpDown E{p}; g8::gemm8<EpiExpDown, SchedExpDown, false, true>(lds, 1024u, 1024u, S, E); }
    xcd_barrier(xbar);
    phase_final(p, bid, nblk);
}

extern "C" void kernel_launch(void* const* d_in, const int* in_sizes, int n_in, void* d_out, int out_size, void* d_ws, size_t ws_size, hipStream_t stream) {
    static int grid_blocks = 0;
    if (!grid_blocks) {
        int dev = 0, cus = 0, per_cu = 0;
        (void)hipGetDevice(&dev);
        (void)hipDeviceGetAttribute(&cus, hipDeviceAttributeMultiprocessorCount, dev);
        (void)hipFuncSetAttribute((const void*)mega, hipFuncAttributeMaxDynamicSharedMemorySize, SMEM_BYTES);
        (void)hipOccupancyMaxActiveBlocksPerMultiprocessor(&per_cu, mega, NT, SMEM_BYTES);
        if (per_cu > 1) per_cu = 1;
        grid_blocks = cus * per_cu;
    }
    KArgs ka{};
    for (int i = 0; i < 25; ++i) ka.in[i] = (const float*)d_in[i];
    ka.out = (float*)d_out; ka.ws = (char*)d_ws; ka.bar = (unsigned*)((char*)d_ws + (size_t)510 * (1u << 20));
    (void)hipMemsetAsync(ka.bar, 0, 49152, stream);
    void* args[] = {&ka};
    hipError_t e = hipLaunchCooperativeKernel((const void*)mega, dim3(grid_blocks), dim3(NT), args, SMEM_BYTES, stream);
    if (e != hipSuccess) fprintf(stderr, "cooperative launch failed: %s (grid %d)\n", hipGetErrorString(e), grid_blocks);
}
```
